# Optimizing an MI355X kernel written in HIP

```python
import math
import jax
import jax.numpy as jnp
from jax import lax
import numpy as np

D_MODEL = 2048
BATCH = 4
SEQ = 4096
DEPTH = 2

CTX_LEN = 256
GRID_W = 64
EPS = 1e-6

MIX_WIDTH = D_MODEL

S5_GROUP = 16
S5_WIDTH = MIX_WIDTH // 4
S5_GROUPS = S5_WIDTH // S5_GROUP
S5_STATE = 64

SSD_HEAD_DIM = 64
SSD_WIDTH = MIX_WIDTH - S5_WIDTH
SSD_HEADS = SSD_WIDTH // SSD_HEAD_DIM
SSD_GROUPS = 4
SSD_STATE = 128
SSD_CHUNK = 128
SSD_CONV_DIM = SSD_WIDTH + 2 * SSD_GROUPS * SSD_STATE

SHORT_CONV_W = 3

GDN_HEAD_DIM = 128
GDN_WIDTH = MIX_WIDTH // 2
GDN_HEADS = GDN_WIDTH // GDN_HEAD_DIM
GDN_CHUNK = 64

MLSTM_V_DIM = 256
MLSTM_QK_DIM = 128
MLSTM_WIDTH = MIX_WIDTH - GDN_WIDTH
MLSTM_HEADS = MLSTM_WIDTH // MLSTM_V_DIM
MLSTM_CHUNK = 64

FFN_DIM = 5504
FFN_CONV_W = 3

EVEN_SPLITS = [S5_WIDTH, S5_WIDTH + SSD_WIDTH, S5_WIDTH + SSD_WIDTH + SSD_CONV_DIM]
EVEN_IN = S5_WIDTH + SSD_WIDTH + SSD_CONV_DIM + 2 * SSD_HEADS
_ODD_SIZES = [3 * GDN_WIDTH, GDN_WIDTH, 2 * GDN_HEADS, 2 * GDN_HEADS,
              MLSTM_HEADS * MLSTM_QK_DIM, MLSTM_HEADS * MLSTM_QK_DIM, MLSTM_WIDTH, MLSTM_WIDTH,
              2 * MLSTM_HEADS, 2 * MLSTM_HEADS]
ODD_SPLITS = [sum(_ODD_SIZES[:i + 1]) for i in range(len(_ODD_SIZES) - 1)]
ODD_IN = sum(_ODD_SIZES)

kernel_name = 'hybrid_s5_ssd_gdn_mlstm_dit'


def _rmsnorm(x, w):
    xf = x.astype(jnp.float32)
    y = xf * lax.rsqrt(jnp.mean(xf * xf, axis=-1, keepdims=True) + EPS)
    return (y * w.astype(jnp.float32)).astype(x.dtype)


def _l2norm(x):
    return x * lax.rsqrt(jnp.sum(x * x, axis=-1, keepdims=True) + EPS)


def _modulate(h, shift, scale):
    return h * (1.0 + scale) + shift


def _short_conv(x, w):
    width = w.shape[0]
    pad = width // 2
    n = x.shape[1]
    xp = jnp.pad(x, ((0, 0), (pad, pad), (0, 0)))
    y = xp[:, 0:n] * w[0]
    for j in range(1, width):
        y = y + xp[:, j:j + n] * w[j]
    return y


def _dwconv2d(x, w):
    return lax.conv_general_dilated(
        x, w[:, :, None, :].astype(x.dtype), window_strides=(1, 1), padding='SAME',
        dimension_numbers=('NHWC', 'HWIO', 'NHWC'), feature_group_count=x.shape[-1])


def _heads_first(t, chunk):
    bsz, n = t.shape[0], t.shape[1]
    t = t.reshape((bsz, n // chunk, chunk) + t.shape[2:])
    return jnp.moveaxis(t, 3, 2)


def _seq_from_chunks(t):
    t = jnp.moveaxis(t, 2, 3)
    return t.reshape((t.shape[0], t.shape[1] * t.shape[2]) + t.shape[3:])


def _lin_combine(left, right):
    a_l, b_l = left
    a_r, b_r = right
    return a_l * a_r, a_r * b_l + b_r


def _s5_scan(u, lam_re, lam_im, log_step, b_re, b_im, c_re, c_im, x0):
    f32 = jnp.float32
    lam = lax.complex(lam_re.astype(f32), lam_im.astype(f32))
    lam_bar = jnp.exp(lam * jnp.exp(log_step.astype(f32))[:, None])
    b_bar = ((lam_bar - 1.0) / lam)[:, :, None] * lax.complex(b_re.astype(f32), b_im.astype(f32))
    bu = jnp.einsum('blgh,gph->blgp', u.astype(jnp.complex64), b_bar)
    bu = bu.at[:, 0].add(lam_bar * x0)
    a = jnp.broadcast_to(lam_bar, bu.shape)
    _, states = lax.associative_scan(_lin_combine, (a, bu), axis=1)
    c = lax.complex(c_re.astype(f32), c_im.astype(f32))
    y = jnp.real(jnp.einsum('blgp,ghp->blgh', states, c))
    return y, states[:, -1]


def _s5_branch(u, p, init):
    f32 = jnp.float32
    bsz, n, _ = u.shape
    uf = u.astype(f32).reshape(bsz, n, S5_GROUPS, S5_GROUP)
    y = p['s5_d'].astype(f32).reshape(S5_GROUPS, S5_GROUP) * uf
    finals = []
    for d in range(2):
        ud = uf if d == 0 else jnp.flip(uf, axis=1)
        x0 = jnp.zeros((bsz, S5_GROUPS, S5_STATE), jnp.complex64) if init is None else init[d]
        yd, xf = _s5_scan(ud, p['s5_lam_re'][d], p['s5_lam_im'][d], p['s5_log_step'][d],
                          p['s5_b_re'][d], p['s5_b_im'][d], p['s5_c_re'][d], p['s5_c_im'][d], x0)
        y = y + (yd if d == 0 else jnp.flip(yd, axis=1))
        finals.append(xf)
    y = jax.nn.gelu(y.reshape(bsz, n, S5_WIDTH))
    y = y * jax.nn.sigmoid(y @ p['s5_glu_w'].astype(f32))
    return y, finals


def _ssd_chunked(x, dt, a_neg, bm, cm, s0):
    bsz, n, nh, hp = x.shape
    ng, ns = bm.shape[2], bm.shape[3]
    r = nh // ng
    q = SSD_CHUNK
    nc = n // q
    la = (dt * a_neg).reshape(bsz, nc, q, ng, r)
    xdt = (x * dt[..., None]).reshape(bsz, nc, q, ng, r, hp)
    bc = bm.reshape(bsz, nc, q, ng, ns)
    cc = cm.reshape(bsz, nc, q, ng, ns)
    cum = jnp.cumsum(la, axis=2)
    tri = jnp.tril(jnp.ones((q, q), bool))[:, :, None, None]
    seg = jnp.where(tri, cum[:, :, :, None] - cum[:, :, None, :], -jnp.inf)
    w_intra = jnp.einsum('bcign,bcjgn->bcijg', cc, bc)[..., None] * jnp.exp(seg)
    y_intra = jnp.einsum('bcijgr,bcjgrp->bcigrp', w_intra, xdt)
    dec_end = jnp.exp(cum[:, :, -1:] - cum)
    st = jnp.einsum('bcjgn,bcjgr,bcjgrp->bcgrpn', bc, dec_end, xdt)
    chunk_dec = jnp.exp(cum[:, :, -1])

    def step(s, inp):
        st_c, dec_c = inp
        return dec_c[..., None, None] * s + st_c, s

    s_fin, s_in = lax.scan(step, s0.reshape(bsz, ng, r, hp, ns),
                           (jnp.moveaxis(st, 1, 0), jnp.moveaxis(chunk_dec, 1, 0)))
    s_in = jnp.moveaxis(s_in, 0, 1)
    y_inter = jnp.einsum('bcign,bcgrpn->bcigrp', cc, s_in) * jnp.exp(cum)[..., None]
    y = (y_intra + y_inter).reshape(bsz, n, nh, hp)
    return y, s_fin.reshape(bsz, nh, hp, ns)


def _ssd_branch(z, xbc, dt_raw, p, init):
    f32 = jnp.float32
    bsz, n, _ = z.shape
    xbc = jax.nn.silu(_short_conv(xbc, p['ssd_conv_w']) + p['ssd_conv_b']).astype(f32)
    xs, bm, cm = jnp.split(xbc, [SSD_WIDTH, SSD_WIDTH + SSD_GROUPS * SSD_STATE], axis=-1)
    xs = xs.reshape(bsz, n, SSD_HEADS, SSD_HEAD_DIM)
    bm = bm.reshape(bsz, n, SSD_GROUPS, SSD_STATE)
    cm = cm.reshape(bsz, n, SSD_GROUPS, SSD_STATE)
    dt_raw = dt_raw.astype(f32).reshape(bsz, n, 2, SSD_HEADS)
    ys, finals = [], []
    for d in range(2):
        dt = jax.nn.softplus(dt_raw[:, :, d] + p['ssd_dt_bias'][d].astype(f32))
        a_neg = -jnp.exp(p['ssd_a_log'][d].astype(f32))
        seqs = (xs, dt, bm, cm) if d == 0 else tuple(jnp.flip(t, axis=1) for t in (xs, dt, bm, cm))
        s0 = jnp.zeros((bsz, SSD_HEADS, SSD_HEAD_DIM, SSD_STATE), f32) if init is None else init[d]
        yd, sf = _ssd_chunked(seqs[0], seqs[1], a_neg, seqs[2], seqs[3], s0)
        ys.append(yd if d == 0 else jnp.flip(yd, axis=1))
        finals.append(sf)
    y = ys[0] + ys[1] + p['ssd_d'].astype(f32)[:, None] * xs
    y = y.reshape(bsz, n, SSD_WIDTH) * jax.nn.silu(z.astype(f32))
    gw = SSD_WIDTH // SSD_GROUPS
    y = _rmsnorm(y.reshape(bsz, n, SSD_GROUPS, gw), p['ssd_norm_w'].reshape(SSD_GROUPS, gw))
    return y.reshape(bsz, n, SSD_WIDTH), finals


def _gdn_chunked(q, k, v, g, beta, s0):
    kd = q.shape[-1]
    vd = v.shape[-1]
    qn = GDN_CHUNK
    qc = _heads_first(q * kd ** -0.5, qn)
    kc = _heads_first(k, qn)
    vc = _heads_first(v, qn)
    gc = _heads_first(g, qn)
    bc = _heads_first(beta, qn)
    gcum = jnp.cumsum(gc, axis=-1)
    incl = jnp.tril(jnp.ones((qn, qn), bool))
    strict = jnp.tril(jnp.ones((qn, qn), bool), -1)
    gam = jnp.exp(jnp.where(incl, gcum[..., :, None] - gcum[..., None, :], -jnp.inf))
    a_mat = jnp.where(strict, bc[..., :, None] * jnp.einsum('bchik,bchjk->bchij', kc, kc) * gam, 0.0)
    rhs = jnp.concatenate([vc * bc[..., None], kc * (bc * jnp.exp(gcum))[..., None]], axis=-1)
    sol = lax.linalg.triangular_solve(a_mat + jnp.eye(qn, dtype=a_mat.dtype), rhs,
                                      left_side=True, lower=True, unit_diagonal=True)
    u_c, w_c = sol[..., :vd], sol[..., vd:]
    qk = jnp.einsum('bchik,bchjk->bchij', qc, kc) * gam
    q_dec = qc * jnp.exp(gcum)[..., None]
    k_dec = kc * jnp.exp(gcum[..., -1:] - gcum)[..., None]
    g_end = jnp.exp(gcum[..., -1])

    def step(s, inp):
        u_i, w_i, qk_i, qd_i, kd_i, ge_i = inp
        v_new = u_i - jnp.einsum('bhqk,bhkv->bhqv', w_i, s)
        o = jnp.einsum('bhqk,bhkv->bhqv', qd_i, s) + jnp.einsum('bhij,bhjv->bhiv', qk_i, v_new)
        s = ge_i[..., None, None] * s + jnp.einsum('bhqk,bhqv->bhkv', kd_i, v_new)
        return s, o

    s_fin, o = lax.scan(step, s0, tuple(jnp.moveaxis(t, 1, 0) for t in (u_c, w_c, qk, q_dec, k_dec, g_end)))
    return _seq_from_chunks(jnp.moveaxis(o, 0, 1)), s_fin


def _gdn_branch(qkv, z, beta_raw, a_raw, p, init):
    f32 = jnp.float32
    bsz, n, _ = qkv.shape
    qkv = jax.nn.silu(_short_conv(qkv, p['gdn_conv_w'])).astype(f32)
    q, k, v = jnp.split(qkv, 3, axis=-1)
    shp = (bsz, n, GDN_HEADS, GDN_HEAD_DIM)
    q = _l2norm(q.reshape(shp))
    k = _l2norm(k.reshape(shp))
    v = v.reshape(shp)
    beta = jax.nn.sigmoid(beta_raw.astype(f32)).reshape(bsz, n, 2, GDN_HEADS)
    a_raw = a_raw.astype(f32).reshape(bsz, n, 2, GDN_HEADS)
    outs, finals = [], []
    for d in range(2):
        g = -jnp.exp(p['gdn_a_log'][d].astype(f32)) * jax.nn.softplus(a_raw[:, :, d] + p['gdn_dt_bias'][d].astype(f32))
        seqs = (q, k, v, g, beta[:, :, d])
        if d == 1:
            seqs = tuple(jnp.flip(t, axis=1) for t in seqs)
        s0 = jnp.zeros((bsz, GDN_HEADS, GDN_HEAD_DIM, GDN_HEAD_DIM), f32) if init is None else init[d]
        od, sf = _gdn_chunked(*seqs, s0)
        outs.append(od if d == 0 else jnp.flip(od, axis=1))
        finals.append(sf)
    o = _rmsnorm(outs[0] + outs[1], p['gdn_norm_w']) * jax.nn.silu(z.astype(f32).reshape(shp))
    return o.reshape(bsz, n, GDN_WIDTH), finals


def _mlstm_chunked(q, k, v, i_pre, logf, state0):
    kd = q.shape[-1]
    qn = MLSTM_CHUNK
    qc = _heads_first(q, qn)
    kc = _heads_first(k * kd ** -0.5, qn)
    vc = _heads_first(v, qn)
    ic = _heads_first(i_pre, qn)
    bcum = jnp.cumsum(_heads_first(logf, qn), axis=-1)
    b_end = bcum[..., -1]
    a_end = b_end[..., None] - bcum + ic
    m_loc = jnp.max(a_end, axis=-1)
    w_end = jnp.exp(a_end - m_loc[..., None])
    c_loc = jnp.einsum('bchq,bchqk,bchqv->bchkv', w_end, kc, vc)
    n_loc = jnp.einsum('bchq,bchqk->bchk', w_end, kc)

    def step(carry, inp):
        c_st, n_st, m_st = carry
        cl, nl, ml, be = inp
        m_new = jnp.maximum(be + m_st, ml)
        s_old = jnp.exp(be + m_st - m_new)
        s_new = jnp.exp(ml - m_new)
        c_next = s_old[..., None, None] * c_st + s_new[..., None, None] * cl
        n_next = s_old[..., None] * n_st + s_new[..., None] * nl
        return (c_next, n_next, m_new), (c_st, n_st, m_st)

    final, (c_in, n_in, m_in) = lax.scan(
        step, state0, tuple(jnp.moveaxis(t, 1, 0) for t in (c_loc, n_loc, m_loc, b_end)))
    c_in, n_in, m_in = (jnp.moveaxis(t, 0, 1) for t in (c_in, n_in, m_in))
    tri = jnp.tril(jnp.ones((qn, qn), bool))
    dmat = jnp.where(tri, bcum[..., :, None] - bcum[..., None, :] + ic[..., None, :], -jnp.inf)
    inter = bcum + m_in[..., None]
    m_row = jnp.maximum(inter, jnp.max(dmat, axis=-1))
    w_row = jnp.exp(dmat - m_row[..., None])
    w_int = jnp.exp(inter - m_row)
    s = jnp.einsum('bchik,bchjk->bchij', qc, kc) * w_row
    num = w_int[..., None] * jnp.einsum('bchik,bchkv->bchiv', qc, c_in) + jnp.einsum('bchij,bchjv->bchiv', s, vc)
    den = w_int * jnp.einsum('bchik,bchk->bchi', qc, n_in) + jnp.sum(s, axis=-1)
    h = num / jnp.maximum(jnp.abs(den), jnp.exp(-m_row))[..., None]
    return _seq_from_chunks(h), final


def _mlstm_branch(q, k, v, o_raw, i_raw, f_raw, p, init):
    f32 = jnp.float32
    bsz, n, _ = q.shape
    q = q.astype(f32).reshape(bsz, n, MLSTM_HEADS, MLSTM_QK_DIM)
    k = k.astype(f32).reshape(bsz, n, MLSTM_HEADS, MLSTM_QK_DIM)
    v = v.astype(f32).reshape(bsz, n, MLSTM_HEADS, MLSTM_V_DIM)
    i_raw = i_raw.astype(f32).reshape(bsz, n, 2, MLSTM_HEADS)
    f_raw = f_raw.astype(f32).reshape(bsz, n, 2, MLSTM_HEADS)
    outs, finals = [], []
    for d in range(2):
        i_pre = i_raw[:, :, d] + p['mlstm_igate_b'][d].astype(f32)
        logf = jax.nn.log_sigmoid(f_raw[:, :, d] + p['mlstm_fgate_b'][d].astype(f32))
        seqs = (q, k, v, i_pre, logf)
        if d == 1:
            seqs = tuple(jnp.flip(t, axis=1) for t in seqs)
        if init is None:
            st0 = (jnp.zeros((bsz, MLSTM_HEADS, MLSTM_QK_DIM, MLSTM_V_DIM), f32),
                   jnp.zeros((bsz, MLSTM_HEADS, MLSTM_QK_DIM), f32),
                   jnp.zeros((bsz, MLSTM_HEADS), f32))
        else:
            st0 = init[d]
        hd, sf = _mlstm_chunked(*seqs, st0)
        outs.append(hd if d == 0 else jnp.flip(hd, axis=1))
        finals.append(sf)
    h = _rmsnorm(outs[0] + outs[1], p['mlstm_norm_w'].reshape(MLSTM_HEADS, MLSTM_V_DIM))
    h = h * jax.nn.sigmoid(o_raw.astype(f32).reshape(bsz, n, MLSTM_HEADS, MLSTM_V_DIM))
    return h.reshape(bsz, n, MLSTM_WIDTH), finals


def _even_core(h, p, init):
    proj = h @ p['in_w']
    u, z, xbc, dt_raw = jnp.split(proj, EVEN_SPLITS, axis=-1)
    y_a, st_a = _s5_branch(u, p, None if init is None else init[0])
    y_b, st_b = _ssd_branch(z, xbc, dt_raw, p, None if init is None else init[1])
    return jnp.concatenate([y_a, y_b], axis=-1).astype(h.dtype), (st_a, st_b)


def _odd_core(h, p, init):
    proj = h @ p['in_w']
    qkv, zg, beta_raw, a_raw, qm, km, vm, om, ig, fg = jnp.split(proj, ODD_SPLITS, axis=-1)
    y_c, st_c = _gdn_branch(qkv, zg, beta_raw, a_raw, p, None if init is None else init[0])
    y_d, st_d = _mlstm_branch(qm, km, vm, om, ig, fg, p, None if init is None else init[1])
    return jnp.concatenate([y_c, y_d], axis=-1).astype(h.dtype), (st_c, st_d)


def _conv_ffn(h, up_w, conv_w, down_w, rows, cols):
    bsz, n, _ = h.shape
    a, v = jnp.split(h @ up_w, 2, axis=-1)
    a = _dwconv2d(a.reshape(bsz, rows, cols, FFN_DIM), conv_w).reshape(bsz, n, FFN_DIM)
    return (jax.nn.silu(a) * v) @ down_w


def setup_inputs(seed: int = 0) -> dict:
    key = jax.random.key(seed)
    keys = jax.random.split(key, 64)
    counter = [0]
    f32 = jnp.float32
    n_even = (DEPTH + 1) // 2
    n_odd = DEPTH // 2

    def nxt():
        kk = keys[counter[0]]
        counter[0] += 1
        return kk

    def normal(shape, scale):
        return scale * jax.random.normal(nxt(), shape, f32)

    def gain(shape):
        return 1.0 + normal(shape, 0.05)

    def dt_bias(shape):
        dt = jnp.exp(jax.random.uniform(nxt(), shape, f32, math.log(1e-3), math.log(1e-1)))
        return dt + jnp.log(-jnp.expm1(-dt))

    def a_log(shape):
        return jnp.log(jax.random.uniform(nxt(), shape, f32, 1.0, 16.0))

    s5_ax = (n_even, 2, S5_GROUPS)
    return {
        'x': normal((BATCH, SEQ, D_MODEL), 1.0),
        'c': normal((BATCH, D_MODEL), 1.0),
        'ctx': normal((BATCH, CTX_LEN, D_MODEL), 1.0),
        'c_ctx': normal((D_MODEL,), 1.0),
        'mod_w': normal((DEPTH, D_MODEL, 6 * D_MODEL), 0.5 * D_MODEL ** -0.5),
        'mod_b': normal((DEPTH, 6 * D_MODEL), 0.02),
        'norm_mix_w': gain((DEPTH, D_MODEL)),
        'norm_ffn_w': gain((DEPTH, D_MODEL)),
        'ffn_up_w': normal((DEPTH, D_MODEL, 2 * FFN_DIM), D_MODEL ** -0.5),
        'ffn_conv_w': normal((DEPTH, FFN_CONV_W, FFN_CONV_W, FFN_DIM), 1.0 / FFN_CONV_W),
        'ffn_down_w': normal((DEPTH, FFN_DIM, D_MODEL), FFN_DIM ** -0.5),
        'final_norm_w': gain((D_MODEL,)),
        'ev_in_w': normal((n_even, D_MODEL, EVEN_IN), D_MODEL ** -0.5),
        'ev_out_w': normal((n_even, MIX_WIDTH, D_MODEL), MIX_WIDTH ** -0.5),
        's5_lam_re': -0.5 + normal(s5_ax + (S5_STATE,), 0.01),
        's5_lam_im': math.pi * jnp.arange(S5_STATE, dtype=f32) + normal(s5_ax + (S5_STATE,), 0.01),
        's5_log_step': jax.random.uniform(nxt(), s5_ax, f32, math.log(1e-3), math.log(1e-1)),
        's5_b_re': normal(s5_ax + (S5_STATE, S5_GROUP), (2 * S5_GROUP) ** -0.5),
        's5_b_im': normal(s5_ax + (S5_STATE, S5_GROUP), (2 * S5_GROUP) ** -0.5),
        's5_c_re': normal(s5_ax + (S5_GROUP, S5_STATE), S5_STATE ** -0.5),
        's5_c_im': normal(s5_ax + (S5_GROUP, S5_STATE), S5_STATE ** -0.5),
        's5_d': normal((n_even, S5_WIDTH), 1.0),
        's5_glu_w': normal((n_even, S5_WIDTH, S5_WIDTH), S5_WIDTH ** -0.5),
        'ssd_conv_w': normal((n_even, SHORT_CONV_W, SSD_CONV_DIM), SHORT_CONV_W ** -0.5),
        'ssd_conv_b': normal((n_even, SSD_CONV_DIM), 0.02),
        'ssd_dt_bias': dt_bias((n_even, 2, SSD_HEADS)),
        'ssd_a_log': a_log((n_even, 2, SSD_HEADS)),
        'ssd_d': 1.0 + normal((n_even, SSD_HEADS), 0.1),
        'ssd_norm_w': gain((n_even, SSD_WIDTH)),
        'od_in_w': normal((n_odd, D_MODEL, ODD_IN), D_MODEL ** -0.5),
        'od_out_w': normal((n_odd, MIX_WIDTH, D_MODEL), MIX_WIDTH ** -0.5),
        'gdn_conv_w': normal((n_odd, SHORT_CONV_W, 3 * GDN_WIDTH), SHORT_CONV_W ** -0.5),
        'gdn_dt_bias': dt_bias((n_odd, 2, GDN_HEADS)),
        'gdn_a_log': a_log((n_odd, 2, GDN_HEADS)),
        'gdn_norm_w': gain((n_odd, GDN_HEAD_DIM)),
        'mlstm_igate_b': normal((n_odd, 2, MLSTM_HEADS), 0.1),
        'mlstm_fgate_b': jnp.linspace(3.0, 6.0, MLSTM_HEADS, dtype=f32) + normal((n_odd, 2, MLSTM_HEADS), 0.1),
        'mlstm_norm_w': gain((n_odd, MLSTM_WIDTH)),
    }


def reference(x, c, ctx, c_ctx, mod_w, mod_b, norm_mix_w, norm_ffn_w, ffn_up_w, ffn_conv_w, ffn_down_w,
              final_norm_w, ev_in_w, ev_out_w, s5_lam_re, s5_lam_im, s5_log_step, s5_b_re, s5_b_im,
              s5_c_re, s5_c_im, s5_d, s5_glu_w, ssd_conv_w, ssd_conv_b, ssd_dt_bias, ssd_a_log, ssd_d,
              ssd_norm_w, od_in_w, od_out_w, gdn_conv_w, gdn_dt_bias, gdn_a_log, gdn_norm_w,
              mlstm_igate_b, mlstm_fgate_b, mlstm_norm_w):
    rows = x.shape[1] // GRID_W
    ctx_len = ctx.shape[1]
    xc = ctx
    for layer in range(DEPTH):
        j = layer // 2
        if layer % 2 == 0:
            p = {'in_w': ev_in_w[j], 's5_lam_re': s5_lam_re[j], 's5_lam_im': s5_lam_im[j],
                 's5_log_step': s5_log_step[j], 's5_b_re': s5_b_re[j], 's5_b_im': s5_b_im[j],
                 's5_c_re': s5_c_re[j], 's5_c_im': s5_c_im[j], 's5_d': s5_d[j], 's5_glu_w': s5_glu_w[j],
                 'ssd_conv_w': ssd_conv_w[j], 'ssd_conv_b': ssd_conv_b[j], 'ssd_dt_bias': ssd_dt_bias[j],
                 'ssd_a_log': ssd_a_log[j], 'ssd_d': ssd_d[j], 'ssd_norm_w': ssd_norm_w[j]}
            core, out_w = _even_core, ev_out_w[j]
        else:
            p = {'in_w': od_in_w[j], 'gdn_conv_w': gdn_conv_w[j], 'gdn_dt_bias': gdn_dt_bias[j],
                 'gdn_a_log': gdn_a_log[j], 'gdn_norm_w': gdn_norm_w[j], 'mlstm_igate_b': mlstm_igate_b[j],
                 'mlstm_fgate_b': mlstm_fgate_b[j], 'mlstm_norm_w': mlstm_norm_w[j]}
            core, out_w = _odd_core, od_out_w[j]
        mod = jax.nn.silu(c) @ mod_w[layer] + mod_b[layer]
        mod_c = jax.nn.silu(c_ctx) @ mod_w[layer] + mod_b[layer]
        sh1, sc1, g1, sh2, sc2, g2 = jnp.split(mod[:, None, :], 6, axis=-1)
        csh1, csc1, cg1, csh2, csc2, cg2 = jnp.split(mod_c[None, None, :], 6, axis=-1)
        y_c, ctx_states = core(_modulate(_rmsnorm(xc, norm_mix_w[layer]), csh1, csc1), p, None)
        y_l, _ = core(_modulate(_rmsnorm(x, norm_mix_w[layer]), sh1, sc1), p, ctx_states)
        x = x + g1 * (y_l @ out_w)
        x = x + g2 * _conv_ffn(_modulate(_rmsnorm(x, norm_ffn_w[layer]), sh2, sc2),
                               ffn_up_w[layer], ffn_conv_w[layer], ffn_down_w[layer], rows, GRID_W)
        if layer < DEPTH - 1:
            xc = xc + cg1 * (y_c @ out_w)
            xc = xc + cg2 * _conv_ffn(_modulate(_rmsnorm(xc, norm_ffn_w[layer]), csh2, csc2),
                                      ffn_up_w[layer], ffn_conv_w[layer], ffn_down_w[layer], 1, ctx_len)
    return _rmsnorm(x, final_norm_w)
```

```cpp
#include <hip/hip_runtime.h>
#include <hip/hip_cooperative_groups.h>
#include <cstdio>
namespace cg = cooperative_groups;

#define LAS __attribute__((address_space(3)))
typedef unsigned short bf16_t;
typedef short bf16x8 __attribute__((ext_vector_type(8)));
typedef float f32x4 __attribute__((ext_vector_type(4)));
typedef unsigned u32x4 __attribute__((ext_vector_type(4)));
typedef unsigned u32x2 __attribute__((ext_vector_type(2)));
typedef float f32x2 __attribute__((ext_vector_type(2)));

constexpr int DM = 2048, NBATCH = 4, SEQ = 4096, CTXL = 256;
constexpr int MLAT = NBATCH * SEQ, MCTX = NBATCH * CTXL, MTOT = MLAT + MCTX;
constexpr int NE_MAIN = 4608, NE = 4864, NE_SRC = 4656;
constexpr int NO_MAIN = 7168, NO = 7424, NO_SRC = 7216;
constexpr int FFN = 5504, UPN = 11008;
constexpr int MODN = 6 * DM;
constexpr int NTHR = 512;
constexpr int LDS_BYTES = 136 * 1024;

constexpr size_t al256(size_t x) { return (x + 255) & ~size_t(255); }
constexpr size_t WS_WINE = 0;
constexpr size_t WS_WINO = WS_WINE + al256((size_t)NE * DM * 2);
constexpr size_t WS_WOUT0 = WS_WINO + al256((size_t)NO * DM * 2);
constexpr size_t WS_WOUT1 = WS_WOUT0 + al256((size_t)DM * DM * 2);
constexpr size_t WS_WUP0 = WS_WOUT1 + al256((size_t)DM * DM * 2);
constexpr size_t WS_WUP1 = WS_WUP0 + al256((size_t)UPN * DM * 2);
constexpr size_t WS_WDN0 = WS_WUP1 + al256((size_t)UPN * DM * 2);
constexpr size_t WS_WDN1 = WS_WDN0 + al256((size_t)DM * FFN * 2);
constexpr size_t WS_WGLU = WS_WDN1 + al256((size_t)DM * FFN * 2);
constexpr size_t WS_MODP = WS_WGLU + al256((size_t)512 * 512 * 2);
constexpr size_t WS_MODF = WS_MODP + al256((size_t)32 * 2 * 5 * MODN * 4);
constexpr size_t WS_XC = WS_MODF + al256((size_t)2 * 5 * MODN * 4);
constexpr size_t WS_ACT = WS_XC + al256((size_t)MCTX * DM * 4);
constexpr size_t WS_YBUF = WS_ACT + al256((size_t)MTOT * DM * 2);
constexpr size_t WS_GATES = WS_YBUF + al256((size_t)MTOT * DM * 2);
constexpr size_t WS_DEN = WS_GATES + al256((size_t)MTOT * 64 * 4);
constexpr size_t WS_YS5 = WS_DEN + al256((size_t)2 * MTOT * 4 * 4);
constexpr size_t WS_BIG = WS_YS5 + al256((size_t)MTOT * 512 * 2);
constexpr size_t BIG_PROJ = al256((size_t)MTOT * NO_MAIN * 2);
constexpr size_t BIG_A = BIG_PROJ + al256((size_t)2 * MTOT * DM * 2);
constexpr size_t BIG_B = al256((size_t)MTOT * UPN * 2);
constexpr size_t WS_BARW = WS_BIG + (BIG_A > BIG_B ? BIG_A : BIG_B);
constexpr size_t WS_END = WS_BARW + 16384;

struct Params { const float* in[38]; float* out; unsigned char* ws; };
typedef const __attribute__((address_space(4))) Params CP;
#define OPQ_IDS int tid_ = threadIdx.x; asm volatile("" : "+v"(tid_)); int bid_ = blockIdx.x; asm volatile("" : "+s"(bid_))

__device__ __forceinline__ float bf2f(bf16_t b) { return __uint_as_float(((unsigned)b) << 16); }
typedef __bf16 bf16x2_t __attribute__((ext_vector_type(2)));
__device__ __forceinline__ bf16_t f2bf(float f) { const __bf16 h = (__bf16)f; return __builtin_bit_cast(unsigned short, h); }
__device__ __forceinline__ unsigned pack2(float lo, float hi) { bf16x2_t v; v[0] = (__bf16)lo; v[1] = (__bf16)hi; return __builtin_bit_cast(unsigned, v); }
__device__ __forceinline__ float lo16(unsigned w) { return __uint_as_float(w << 16); }
__device__ __forceinline__ float hi16(unsigned w) { return __uint_as_float(w & 0xFFFF0000u); }
__device__ __forceinline__ float sigmoidf_(float x) { return __builtin_amdgcn_rcpf(1.f + __expf(-x)); }
__device__ __forceinline__ float siluf_(float x) { return x * __builtin_amdgcn_rcpf(1.f + __expf(-x)); }
__device__ __forceinline__ float softplusf_(float x) { return fmaxf(x, 0.f) + log1pf(expf(-fabsf(x))); }
__device__ __forceinline__ float gelu_tanh(float x) { const float u = 0.7978845608028654f * (x + 0.044715f * x * x * x); return 0.5f * x * (1.f + tanhf(u)); }
template <int CTRL> __device__ __forceinline__ float dppmov(float v) { return __int_as_float(__builtin_amdgcn_update_dpp(0, __float_as_int(v), CTRL, 0xF, 0xF, true)); }
__device__ __forceinline__ float red8(float v) { v += dppmov<0xB1>(v); v += dppmov<0x4E>(v); v += dppmov<0x141>(v); return v; }
__device__ __forceinline__ float red16(float v) { v = red8(v); v += dppmov<0x140>(v); return v; }
__device__ __forceinline__ float red32(float v) { v = red16(v); v += __shfl_xor(v, 16, 64); return v; }
__device__ __forceinline__ float red64(float v) { v = red16(v); v += __shfl_xor(v, 16, 64); v += __shfl_xor(v, 32, 64); return v; }

namespace pg8 {
constexpr int BM = 256, BK = 64, HALF = 128, HTB = HALF * BK * 2, STAGE_BYTES = 8 * HTB, NXCD = 8, WGM = 8;
__device__ __forceinline__ int lds_byte(int r, int c) { const int st = (r >> 4) * 2 + (c >> 5), rr = r & 15, cc = c & 31, ob = rr * 64 + cc * 2; return st * 1024 + (ob ^ (((ob >> 9) & 1) << 5)); }
__device__ __forceinline__ void stage_rc(int b, int& R, int& C) { const int st = b / 1024, sb = b % 1024, swz = sb ^ (((sb >> 9) & 1) << 5); R = (st >> 1) * 16 + swz / 64; C = (st & 1) * 32 + (swz % 64) / 2; }
__device__ __forceinline__ int perm32(int rho) { const int n = rho >> 4, i = rho & 15; return 8 * (i >> 2) + 4 * n + (i & 3); }
struct Unit { int pm, pn; };
struct Gemm { const bf16_t* A; const bf16_t* Bt; int M, N, K, lda; };
struct StaticOrder {
    int nM, nN, nwg, G, c;
    __device__ void init(int M, int N, int G_, int c_) { nM = M / BM; nN = N / BM; nwg = nM * nN; G = G_; c = c_; }
    __device__ bool next(int i, Unit& u) const {
        const long L = (long)i * G + c; if (L >= nwg) return false;
        int wgid = (int)L; { const int q = nwg / NXCD, r = nwg % NXCD, xcd = wgid % NXCD, off = wgid / NXCD; wgid = (xcd < r ? xcd * (q + 1) : r * (q + 1) + (xcd - r) * q) + off; }
        const int nig = WGM * nN, gid = wgid / nig, fm = gid * WGM, gsz = (nM - fm) < WGM ? (nM - fm) : WGM;
        u.pm = fm + ((wgid % nig) % gsz); u.pn = (wgid % nig) / gsz; return true;
    }
};
__device__ __forceinline__ unsigned cvt_pk_bf16(float lo, float hi) { unsigned r; asm volatile("v_cvt_pk_bf16_f32 %0, %1, %2" : "=v"(r) : "v"(lo), "v"(hi)); return r; }

template <class Epi>
__device__ __forceinline__ void gemm_phase(LAS unsigned char* lds, const Gemm g, const StaticOrder& S, const Epi& E) {
    int tid = threadIdx.x; asm volatile("" : "+v"(tid));
    const int wid = __builtin_amdgcn_readfirstlane(tid >> 6), lane = tid & 63, wr = wid >> 2, wc = wid & 3, fr = lane & 15, fq = lane >> 4;
    const int K = g.K, nt = K / BK, lda = g.lda;
    unsigned voffA[2], voffB[2];
#pragma unroll
    for (int i = 0; i < 2; ++i) { int R, C; stage_rc(tid * 16 + i * 8192, R, C); const int Rb = Epi::PERM ? ((R & ~31) + perm32(R & 31)) : R;
        voffA[i] = (unsigned)(R * lda + C) * 2u; voffB[i] = (unsigned)(Rb * K + C) * 2u; }
    const size_t kstep = (size_t)(BK * 2);
    const size_t hstepA = (size_t)HALF * lda * 2, hstepB = (size_t)HALF * K * 2;
    const size_t tstepA = 2 * hstepA, tstepB = 2 * hstepB;
    const unsigned ldsw = (unsigned)wid * 1024u;
    const int aoff = lds_byte(wr * 64 + fr, fq * 8), boff = lds_byte(wc * 32 + fr, fq * 8);
#define PG8_SA(b, h) (((b) * 2 + (h)) * HTB)
#define PG8_SB(b, h) ((4 + (b) * 2 + (h)) * HTB)
#define PG8_STAGE(bufoff, gbase, voff) do { _Pragma("unroll") for (int _i = 0; _i < 2; ++_i) \
        __builtin_amdgcn_global_load_lds((const unsigned*)((const char*)(gbase) + (voff)[_i]), (LAS unsigned*)(lds + (bufoff) + ldsw + _i * 8192), 16, 0, 0); } while (0)
#define PG8_LDA(dst, b, h) do { _Pragma("unroll") for (int m = 0; m < 4; ++m) _Pragma("unroll") for (int k = 0; k < 2; ++k) dst[m][k] = *(const LAS bf16x8*)(lds + PG8_SA(b, h) + aoff + m * 2048 + k * 1024); } while (0)
#define PG8_LDB(dst, b, h) do { _Pragma("unroll") for (int n = 0; n < 2; ++n) _Pragma("unroll") for (int k = 0; k < 2; ++k) dst[n][k] = *(const LAS bf16x8*)(lds + PG8_SB(b, h) + boff + n * 2048 + k * 1024); } while (0)
#define PG8_MMA(ai, bj, At, Bt) do { __builtin_amdgcn_s_setprio(1); _Pragma("unroll") for (int m = 0; m < 4; ++m) _Pragma("unroll") for (int n = 0; n < 2; ++n) _Pragma("unroll") for (int k = 0; k < 2; ++k) \
        acc[ai][bj][m][n] = __builtin_amdgcn_mfma_f32_16x16x32_bf16(Bt[n][k], At[m][k], acc[ai][bj][m][n], 0, 0, 0); __builtin_amdgcn_s_setprio(0); } while (0)
#define PG8_WAIT_V(n) asm volatile("s_waitcnt vmcnt(" #n ")" ::: "memory")
#define PG8_WAIT_L(n) asm volatile("s_waitcnt lgkmcnt(" #n ")" ::: "memory")
#define PG8_BAR __builtin_amdgcn_s_barrier()
#define PG8_SCHED __builtin_amdgcn_sched_barrier(0)
    Unit cur, nxt; int ui = 0;
    if (!S.next(0, cur)) return;
    f32x4 acc[2][2][4][2];
#pragma unroll
    for (int a = 0; a < 2; ++a)
#pragma unroll
        for (int b = 0; b < 2; ++b)
#pragma unroll
            for (int m = 0; m < 4; ++m)
#pragma unroll
                for (int n = 0; n < 2; ++n) acc[a][b][m][n] = (f32x4){0.f, 0.f, 0.f, 0.f};
    bf16x8 At[4][2], B0[2][2], B1[2][2];
    const char* cA = (const char*)g.A + (size_t)cur.pm * tstepA; const char* cB = (const char*)g.Bt + (size_t)cur.pn * tstepB;
    PG8_STAGE(PG8_SB(0, 0), cB, voffB); PG8_STAGE(PG8_SA(0, 0), cA, voffA); PG8_STAGE(PG8_SB(0, 1), cB + hstepB, voffB); PG8_STAGE(PG8_SA(0, 1), cA + hstepA, voffA);
    if (wr == 1) PG8_BAR;
    PG8_WAIT_V(4); PG8_BAR;
    PG8_STAGE(PG8_SB(1, 0), cB + kstep, voffB); PG8_STAGE(PG8_SA(1, 0), cA + kstep, voffA); PG8_STAGE(PG8_SB(1, 1), cB + hstepB + kstep, voffB);
    PG8_WAIT_V(6); PG8_BAR;
    for (;;) {
        const bool has_next = S.next(ui + 1, nxt);
        const char* nA = has_next ? (const char*)g.A + (size_t)nxt.pm * tstepA : cA; const char* nB = has_next ? (const char*)g.Bt + (size_t)nxt.pn * tstepB : cB;
        for (int t = 0; t < nt; t += 2) {
            const bool last = (t == nt - 2);
            const char* a1 = cA + (size_t)(t + 1) * kstep;
            const char* a2 = last ? nA : cA + (size_t)(t + 2) * kstep; const char* b2 = last ? nB : cB + (size_t)(t + 2) * kstep;
            const char* a3 = a2 + kstep; const char* b3 = b2 + kstep;
            PG8_LDB(B0, 0, 0); PG8_SCHED; PG8_LDA(At, 0, 0); PG8_STAGE(PG8_SA(1, 1), a1 + hstepA, voffA);
            PG8_WAIT_L(8); PG8_BAR; PG8_WAIT_L(0); PG8_MMA(0, 0, At, B0); PG8_BAR; PG8_SCHED;
            PG8_LDB(B1, 0, 1); PG8_STAGE(PG8_SB(0, 0), b2, voffB);
            PG8_BAR; PG8_WAIT_L(0); PG8_MMA(0, 1, At, B1); PG8_BAR;
            PG8_LDA(At, 0, 1); PG8_STAGE(PG8_SA(0, 0), a2, voffA);
            PG8_BAR; PG8_WAIT_L(0); PG8_MMA(1, 0, At, B0); PG8_BAR; PG8_SCHED;
            PG8_STAGE(PG8_SB(0, 1), b2 + hstepB, voffB);
            PG8_WAIT_V(6); PG8_BAR; PG8_MMA(1, 1, At, B1); PG8_BAR;
            PG8_LDB(B0, 1, 0); PG8_SCHED; PG8_LDA(At, 1, 0); PG8_STAGE(PG8_SA(0, 1), a2 + hstepA, voffA);
            PG8_WAIT_L(8); PG8_BAR; PG8_WAIT_L(0); PG8_MMA(0, 0, At, B0); PG8_BAR; PG8_SCHED;
            PG8_LDB(B1, 1, 1); PG8_STAGE(PG8_SB(1, 0), b3, voffB);
            PG8_BAR; PG8_WAIT_L(0); PG8_MMA(0, 1, At, B1); PG8_BAR;
            PG8_LDA(At, 1, 1); PG8_STAGE(PG8_SA(1, 0), a3, voffA);
            PG8_BAR; PG8_WAIT_L(0); PG8_MMA(1, 0, At, B0); PG8_BAR; PG8_SCHED;
            PG8_STAGE(PG8_SB(1, 1), b3 + hstepB, voffB);
            PG8_WAIT_V(6); PG8_BAR; PG8_MMA(1, 1, At, B1); PG8_BAR;
        }
        E(acc, cur, wr, wc, fr, fq);
        if (!has_next) break;
#pragma unroll
        for (int a = 0; a < 2; ++a)
#pragma unroll
            for (int b = 0; b < 2; ++b)
#pragma unroll
                for (int m = 0; m < 4; ++m)
#pragma unroll
                    for (int n = 0; n < 2; ++n) acc[a][b][m][n] = (f32x4){0.f, 0.f, 0.f, 0.f};
        cur = nxt; cA = nA; cB = nB; ++ui;
    }
    PG8_WAIT_V(0);
    if (wr == 0) PG8_BAR;
    PG8_BAR;
#undef PG8_SA
#undef PG8_SB
#undef PG8_STAGE
#undef PG8_LDA
#undef PG8_LDB
#undef PG8_MMA
#undef PG8_WAIT_V
#undef PG8_WAIT_L
#undef PG8_BAR
#undef PG8_SCHED
}

struct EpiOut {
    static constexpr bool PERM = true;
    bf16_t* O; int ldc; int n_main; float* G;
    __device__ __forceinline__ void operator()(const f32x4 (&acc)[2][2][4][2], const Unit& u, int wr, int wc, int fr, int fq) const {
        const int row0 = u.pm * BM + wr * 64 + fr;
        if (u.pn < n_main) {
            const int col0 = u.pn * BM + wc * 32 + 8 * fq;
#pragma unroll
            for (int ai = 0; ai < 2; ++ai)
#pragma unroll
                for (int m = 0; m < 4; ++m) { bf16_t* rowp = O + (size_t)(row0 + ai * HALF + m * 16) * ldc + col0;
#pragma unroll
                    for (int bj = 0; bj < 2; ++bj) { const f32x4 v0 = acc[ai][bj][m][0], v1 = acc[ai][bj][m][1];
                        u32x4 w; w.x = cvt_pk_bf16(v0[0], v0[1]); w.y = cvt_pk_bf16(v0[2], v0[3]); w.z = cvt_pk_bf16(v1[0], v1[1]); w.w = cvt_pk_bf16(v1[2], v1[3]);
                        *(u32x4*)(rowp + bj * HALF) = w; } }
        } else if (wc < 2) {
#pragma unroll
            for (int ai = 0; ai < 2; ++ai)
#pragma unroll
                for (int m = 0; m < 4; ++m) { float* rowp = G + (size_t)(row0 + ai * HALF + m * 16) * 64 + wc * 32 + 8 * fq;
                    *(f32x4*)(rowp) = acc[ai][0][m][0]; *(f32x4*)(rowp + 4) = acc[ai][0][m][1]; }
        }
    }
};
struct EpiResid {
    static constexpr bool PERM = false;
    const float* xin_lat; const float* xin_ctx; float* xout_lat; float* xout_ctx; const float* gate;
    __device__ __forceinline__ void operator()(const f32x4 (&acc)[2][2][4][2], const Unit& u, int wr, int wc, int fr, int fq) const {
        int rowt = u.pm * BM; const float* xi; float* xo; const float* gv;
        if (rowt < MLAT) { xi = xin_lat + (size_t)rowt * DM; xo = xout_lat + (size_t)rowt * DM; gv = gate + (size_t)(rowt >> 12) * MODN; }
        else { rowt -= MLAT; xi = xin_ctx + (size_t)rowt * DM; xo = xout_ctx + (size_t)rowt * DM; gv = gate + (size_t)4 * MODN; }
        const int lrow0 = wr * 64 + fr, col0 = u.pn * BM + wc * 32 + 4 * fq;
        f32x4 gvv[2][2];
#pragma unroll
        for (int bj = 0; bj < 2; ++bj)
#pragma unroll
            for (int n = 0; n < 2; ++n) gvv[bj][n] = *(const f32x4*)(gv + col0 + bj * HALF + n * 16);
#pragma unroll
        for (int ai = 0; ai < 2; ++ai)
#pragma unroll
            for (int m = 0; m < 4; ++m) { const size_t off = (size_t)(lrow0 + ai * HALF + m * 16) * DM + col0;
#pragma unroll
                for (int bj = 0; bj < 2; ++bj)
#pragma unroll
                    for (int n = 0; n < 2; ++n) { const f32x4 xv = *(const f32x4*)(xi + off + bj * HALF + n * 16);
                        *(f32x4*)(xo + off + bj * HALF + n * 16) = xv + gvv[bj][n] * acc[ai][bj][m][n]; } }
    }
};
struct EpiGlu {
    static constexpr bool PERM = true;
    const bf16_t* Y; bf16_t* O;
    __device__ __forceinline__ void operator()(const f32x4 (&acc)[2][2][4][2], const Unit& u, int wr, int wc, int fr, int fq) const {
        const int row0 = u.pm * BM + wr * 64 + fr, col0 = u.pn * BM + wc * 32 + 8 * fq;
#pragma unroll
        for (int ai = 0; ai < 2; ++ai)
#pragma unroll
            for (int m = 0; m < 4; ++m) { const int row = row0 + ai * HALF + m * 16;
#pragma unroll
                for (int bj = 0; bj < 2; ++bj) { const u32x4 yv = *(const u32x4*)(Y + (size_t)row * 512 + col0 + bj * HALF);
                    const f32x4 v0 = acc[ai][bj][m][0], v1 = acc[ai][bj][m][1];
                    u32x4 w;
                    w.x = cvt_pk_bf16(lo16(yv.x) * sigmoidf_(v0[0]), hi16(yv.x) * sigmoidf_(v0[1]));
                    w.y = cvt_pk_bf16(lo16(yv.y) * sigmoidf_(v0[2]), hi16(yv.y) * sigmoidf_(v0[3]));
                    w.z = cvt_pk_bf16(lo16(yv.z) * sigmoidf_(v1[0]), hi16(yv.z) * sigmoidf_(v1[1]));
                    w.w = cvt_pk_bf16(lo16(yv.w) * sigmoidf_(v1[2]), hi16(yv.w) * sigmoidf_(v1[3]));
                    *(u32x4*)(O + (size_t)row * DM + col0 + bj * HALF) = w; } }
    }
};
}

template <class Epi>
__device__ __forceinline__ void run_gemm(unsigned char* shm, const bf16_t* A, int lda, const bf16_t* Bt, int M, int N, int K, const Epi& E) {
    int bid_ = blockIdx.x; asm volatile("" : "+s"(bid_));
    pg8::Gemm g{A, Bt, M, N, K, lda}; pg8::StaticOrder S; S.init(M, N, (int)gridDim.x, bid_);
    pg8::gemm_phase<Epi>((LAS unsigned char*)shm, g, S, E);
}

__device__ __forceinline__ void ld8(const bf16_t* p, float (&v)[8]) { const u32x4 r = *(const u32x4*)p; v[0] = lo16(r.x); v[1] = hi16(r.x); v[2] = lo16(r.y); v[3] = hi16(r.y); v[4] = lo16(r.z); v[5] = hi16(r.z); v[6] = lo16(r.w); v[7] = hi16(r.w); }
__device__ __forceinline__ void st8(bf16_t* p, const float (&v)[8]) { u32x4 w; w.x = pack2(v[0], v[1]); w.y = pack2(v[2], v[3]); w.z = pack2(v[4], v[5]); w.w = pack2(v[6], v[7]); *(u32x4*)p = w; }
__device__ __forceinline__ void ldf8(const float* p, float (&v)[8]) { const f32x4 a = *(const f32x4*)p, b = *(const f32x4*)(p + 4); v[0] = a[0]; v[1] = a[1]; v[2] = a[2]; v[3] = a[3]; v[4] = b[0]; v[5] = b[1]; v[6] = b[2]; v[7] = b[3]; }


struct CvtDesc { const float* src; bf16_t* dst; int K, Nsrc, Ndst, mode; };
__device__ __forceinline__ int cvt_srccol(int mode, int n, int Nsrc) {
    if (mode == 0) return n < Nsrc ? n : -1;
    if (n < 4096) return n;
    if (n < 7168) return n + 32;
    if (n < 7200) return 4096 + (n - 7168);
    if (n < 7216) return n;
    return -1;
}
constexpr int CVT_T0 = 0;
constexpr int CVT_T1 = CVT_T0 + (NE / 256) * (DM / 64);
constexpr int CVT_T2 = CVT_T1 + (NO / 256) * (DM / 64);
constexpr int CVT_T3 = CVT_T2 + (DM / 256) * (DM / 64);
constexpr int CVT_T4 = CVT_T3 + (DM / 256) * (DM / 64);
constexpr int CVT_T5 = CVT_T4 + (UPN / 256) * (DM / 64);
constexpr int CVT_T6 = CVT_T5 + (UPN / 256) * (DM / 64);
constexpr int CVT_T7 = CVT_T6 + (DM / 256) * (FFN / 64);
constexpr int CVT_T8 = CVT_T7 + (DM / 256) * (FFN / 64);
constexpr int CVT_T9 = CVT_T8 + 2 * 8;
constexpr int N_MOD_ITEMS = 2 * 6 * 32;
constexpr int CVT_PITCH = 260;

__device__ void phase_prologue(CP& p, unsigned char* shm) {
    OPQ_IDS;
    const int tid = tid_;
    float* lds = (float*)shm;
    unsigned char* ws = p.ws;
    for (int item = bid_; item < N_MOD_ITEMS + CVT_T9; item += gridDim.x) {
        if (item < N_MOD_ITEMS) {
            const int layer = item / 192, rem = item % 192, cc = rem >> 5, kc = rem & 31;
            if (tid < 320) { const int r = tid >> 6, k = tid & 63; const float v = (r < 4) ? p.in[1][r * DM + kc * 64 + k] : p.in[3][kc * 64 + k]; lds[tid] = v / (1.f + expf(-v)); }
            __syncthreads();
            const int col = cc * 2048 + tid * 4;
            const float* w = p.in[4] + ((size_t)layer * DM + kc * 64) * MODN + col;
            f32x4 a0 = {0.f, 0.f, 0.f, 0.f}, a1 = a0, a2 = a0, a3 = a0, a4 = a0;
#pragma unroll 16
            for (int k = 0; k < 64; ++k) { const f32x4 wv = *(const f32x4*)(w + (size_t)k * MODN); a0 += wv * lds[k]; a1 += wv * lds[64 + k]; a2 += wv * lds[128 + k]; a3 += wv * lds[192 + k]; a4 += wv * lds[256 + k]; }
            float* mp = (float*)(ws + WS_MODP) + ((size_t)(kc * 2 + layer) * 5) * MODN + col;
            *(f32x4*)(mp) = a0; *(f32x4*)(mp + MODN) = a1; *(f32x4*)(mp + 2 * MODN) = a2; *(f32x4*)(mp + 3 * MODN) = a3; *(f32x4*)(mp + 4 * MODN) = a4;
            __syncthreads();
        } else {
            const int t = item - N_MOD_ITEMS;
            CvtDesc c; int tl;
            if (t < CVT_T1)      { c = CvtDesc{p.in[12], (bf16_t*)(ws + WS_WINE), DM, NE_SRC, NE, 0}; tl = t - CVT_T0; }
            else if (t < CVT_T2) { c = CvtDesc{p.in[29], (bf16_t*)(ws + WS_WINO), DM, NO_SRC, NO, 1}; tl = t - CVT_T1; }
            else if (t < CVT_T3) { c = CvtDesc{p.in[13], (bf16_t*)(ws + WS_WOUT0), DM, DM, DM, 0}; tl = t - CVT_T2; }
            else if (t < CVT_T4) { c = CvtDesc{p.in[30], (bf16_t*)(ws + WS_WOUT1), DM, DM, DM, 0}; tl = t - CVT_T3; }
            else if (t < CVT_T5) { c = CvtDesc{p.in[8], (bf16_t*)(ws + WS_WUP0), DM, UPN, UPN, 0}; tl = t - CVT_T4; }
            else if (t < CVT_T6) { c = CvtDesc{p.in[8] + (size_t)DM * UPN, (bf16_t*)(ws + WS_WUP1), DM, UPN, UPN, 0}; tl = t - CVT_T5; }
            else if (t < CVT_T7) { c = CvtDesc{p.in[10], (bf16_t*)(ws + WS_WDN0), FFN, DM, DM, 0}; tl = t - CVT_T6; }
            else if (t < CVT_T8) { c = CvtDesc{p.in[10] + (size_t)FFN * DM, (bf16_t*)(ws + WS_WDN1), FFN, DM, DM, 0}; tl = t - CVT_T7; }
            else                 { c = CvtDesc{p.in[22], (bf16_t*)(ws + WS_WGLU), 512, 512, 512, 0}; tl = t - CVT_T8; }
            const int nkt = c.K / 64, tn = tl / nkt, tk = tl % nkt, n0 = tn * 256, k0 = tk * 64;
            { const int n4 = (tid & 63) * 4, kb = tid >> 6; const int sc = cvt_srccol(c.mode, n0 + n4, c.Nsrc);
              f32x4 v[8];
#pragma unroll
              for (int i = 0; i < 8; ++i) { const int k = i * 8 + kb; v[i] = (sc >= 0) ? *(const f32x4*)(c.src + (size_t)(k0 + k) * c.Nsrc + sc) : (f32x4){0.f, 0.f, 0.f, 0.f}; }
#pragma unroll
              for (int i = 0; i < 8; ++i) { const int k = i * 8 + kb; *(f32x4*)(lds + k * CVT_PITCH + n4) = v[i]; } }
            __syncthreads();
            { const int n = tid >> 1, kh = tid & 1; const float* col = lds + (kh * 32) * CVT_PITCH + n;
              bf16_t* dp = c.dst + (size_t)(n0 + n) * c.K + k0 + kh * 32;
#pragma unroll
              for (int q = 0; q < 4; ++q) { float v[8];
#pragma unroll
                  for (int i = 0; i < 8; ++i) v[i] = col[(q * 8 + i) * CVT_PITCH];
                  st8(dp + q * 8, v); } }
            __syncthreads();
        }
    }
}

__device__ void phase_modreduce(CP& p) {
    OPQ_IDS;
    const float* mp = (const float*)(p.ws + WS_MODP); float* mf = (float*)(p.ws + WS_MODF);
    for (int idx = bid_ * NTHR + tid_; idx < 2 * 5 * MODN; idx += gridDim.x * NTHR) {
        const int layer = idx / (5 * MODN), rem = idx % (5 * MODN), col = rem % MODN;
        float s = p.in[5][layer * MODN + col];
#pragma unroll
        for (int kc = 0; kc < 32; ++kc) s += mp[((size_t)(kc * 2 + layer) * 5) * MODN + rem];
        mf[idx] = s;
    }
}

__device__ void phase_norm(CP& p, int layer, int which, int nrows, bool from_input) {
    OPQ_IDS;
    const int lane = tid_ & 63, wid = tid_ >> 6;
    const float* xc = (const float*)(p.ws + WS_XC); bf16_t* act = (bf16_t*)(p.ws + WS_ACT);
    const float* nw = (which ? p.in[7] : p.in[6]) + layer * DM;
    const float* mf = (const float*)(p.ws + WS_MODF) + (size_t)layer * 5 * MODN;
    for (int row = bid_ * 8 + wid; row < nrows; row += gridDim.x * 8) {
        const float* src; int r;
        if (row < MLAT) { src = (from_input ? p.in[0] : p.out) + (size_t)row * DM; r = row >> 12; }
        else { src = (from_input ? p.in[2] : xc) + (size_t)(row - MLAT) * DM; r = 4; }
        const float* sh = mf + (size_t)r * MODN + (which ? 3 : 0) * DM; const float* sc = mf + (size_t)r * MODN + (which ? 4 : 1) * DM;
        f32x4 v[8]; float ss = 0.f;
#pragma unroll
        for (int j = 0; j < 8; ++j) { v[j] = *(const f32x4*)(src + j * 256 + lane * 4); ss += v[j][0] * v[j][0] + v[j][1] * v[j][1] + v[j][2] * v[j][2] + v[j][3] * v[j][3]; }
        ss = red64(ss);
        const float rs = rsqrtf(ss * (1.f / DM) + 1e-6f);
#pragma unroll
        for (int j = 0; j < 8; ++j) { const int col = j * 256 + lane * 4;
            const f32x4 w4 = *(const f32x4*)(nw + col), s4 = *(const f32x4*)(sh + col), c4 = *(const f32x4*)(sc + col);
            const f32x4 o = (v[j] * rs * w4) * (c4 + 1.f) + s4;
            u32x2 w; w.x = pack2(o[0], o[1]); w.y = pack2(o[2], o[3]);
            *(u32x2*)(act + (size_t)row * DM + col) = w; }
    }
}
__device__ void phase_final_norm(CP& p) {
    OPQ_IDS;
    const int lane = tid_ & 63, wid = tid_ >> 6;
    const float* nw = p.in[11];
    for (int row = bid_ * 8 + wid; row < MLAT; row += gridDim.x * 8) {
        float* src = p.out + (size_t)row * DM;
        f32x4 v[8]; float ss = 0.f;
#pragma unroll
        for (int j = 0; j < 8; ++j) { v[j] = *(const f32x4*)(src + j * 256 + lane * 4); ss += v[j][0] * v[j][0] + v[j][1] * v[j][1] + v[j][2] * v[j][2] + v[j][3] * v[j][3]; }
        ss = red64(ss);
        const float rs = rsqrtf(ss * (1.f / DM) + 1e-6f);
#pragma unroll
        for (int j = 0; j < 8; ++j) { const int col = j * 256 + lane * 4; const f32x4 w4 = *(const f32x4*)(nw + col); *(f32x4*)(src + col) = v[j] * rs * w4; }
    }
}

__device__ void phase_ffnconv(CP& p, int layer, int nrows) {
    OPQ_IDS;
    bf16_t* big = (bf16_t*)(p.ws + WS_BIG);
    const float* cw = p.in[9] + (size_t)layer * 9 * FFN;
    const int nseg = nrows / 32; constexpr int NCG = FFN / 8;
    struct F8 { f32x4 lo, hi; };
    for (long it = (long)bid_ * NTHR + tid_; it < (long)nseg * NCG; it += (long)gridDim.x * NTHR) {
        const int seg = (int)(it / NCG), cgp = (int)(it % NCG), c0 = cgp * 8, row0 = seg * 32;
        const bool lat = row0 < MLAT;
        const int W = lat ? 64 : 256;
        const int x0 = lat ? (row0 & 63) : ((row0 - MLAT) & 255);
        const int y = lat ? ((row0 & 4095) >> 6) : 0;
        const bool up_ok = lat && y > 0, dn_ok = lat && y < 63;
        F8 w[9];
#pragma unroll
        for (int q = 0; q < 9; ++q) { w[q].lo = *(const f32x4*)(cw + (size_t)q * FFN + c0); w[q].hi = *(const f32x4*)(cw + (size_t)q * FFN + c0 + 4); }
        F8 L[3], M[3], R[3];
        auto ldcol = [&](int row, bool ok, F8 (&dst)[3]) {
#pragma unroll
            for (int dy = 0; dy < 3; ++dy) {
                const bool rok = ok && (dy == 1 || (dy == 0 ? up_ok : dn_ok));
                if (rok) { const u32x4 raw = *(const u32x4*)(big + (size_t)(row + (dy - 1) * 64) * UPN + c0);
                    dst[dy].lo = (f32x4){lo16(raw.x), hi16(raw.x), lo16(raw.y), hi16(raw.y)}; dst[dy].hi = (f32x4){lo16(raw.z), hi16(raw.z), lo16(raw.w), hi16(raw.w)}; }
                else { dst[dy].lo = (f32x4){0.f, 0.f, 0.f, 0.f}; dst[dy].hi = (f32x4){0.f, 0.f, 0.f, 0.f}; }
            }
        };
        ldcol(row0 - 1, x0 > 0, L);
        ldcol(row0, true, M);
#pragma unroll 4
        for (int i = 0; i < 32; ++i) {
            const int row = row0 + i;
            ldcol(row + 1, (x0 + i + 1) < W, R);
            f32x4 a = (f32x4){0.f, 0.f, 0.f, 0.f}, bq = (f32x4){0.f, 0.f, 0.f, 0.f};
#pragma unroll
            for (int dy = 0; dy < 3; ++dy) { a += L[dy].lo * w[dy * 3 + 0].lo + M[dy].lo * w[dy * 3 + 1].lo + R[dy].lo * w[dy * 3 + 2].lo;
                bq += L[dy].hi * w[dy * 3 + 0].hi + M[dy].hi * w[dy * 3 + 1].hi + R[dy].hi * w[dy * 3 + 2].hi; }
            bf16_t* vp = big + (size_t)row * UPN + FFN + c0;
            const u32x4 vraw = *(const u32x4*)vp;
            u32x4 o;
            o.x = pack2(siluf_(a[0]) * lo16(vraw.x), siluf_(a[1]) * hi16(vraw.x)); o.y = pack2(siluf_(a[2]) * lo16(vraw.y), siluf_(a[3]) * hi16(vraw.y));
            o.z = pack2(siluf_(bq[0]) * lo16(vraw.z), siluf_(bq[1]) * hi16(vraw.z)); o.w = pack2(siluf_(bq[2]) * lo16(vraw.w), siluf_(bq[3]) * hi16(vraw.w));
            *(u32x4*)vp = o;
#pragma unroll
            for (int dy = 0; dy < 3; ++dy) { L[dy] = M[dy]; M[dy] = R[dy]; }
        }
    }
}

__device__ __forceinline__ int seg_len(int seg) { return seg ? SEQ : CTXL; }
__device__ __forceinline__ int seg_base(int seg, int b) { return seg ? b * SEQ : MLAT + b * CTXL; }

template <bool CONV, int NI = 10> struct StageRaw { u32x2 x0[NI]; u32x2 xm[CONV ? NI : 1]; u32x2 xp[CONV ? NI : 1]; };
__device__ __forceinline__ void chunk_pos(int cidx, int b, int& len, int& rowbase, int& c0) { if (cidx < 4) { len = CTXL; rowbase = MLAT + b * CTXL; c0 = cidx * 64; } else { len = SEQ; rowbase = b * SEQ; c0 = (cidx - 4) * 64; } }
template <bool CONV, int NI, class ColMap>
__device__ __forceinline__ void stage_load(StageRaw<CONV, NI>& r, const bf16_t* proj, int ldp, int rowbase, int len, int c0, int d, ColMap colmap, int tid_) {
    constexpr int NQ = NI * 8;
    asm volatile("" : "+v"(tid_));
#pragma unroll
    for (int k = 0; k < NI; ++k) {
        const int it = tid_ + k * NTHR, i = it / NQ, ch = (it % NQ) * 4;
        const int pi = c0 + i, t = d ? (len - 1 - pi) : pi;
        const bf16_t* pp = proj + (size_t)(rowbase + t) * ldp + colmap(ch);
        r.x0[k] = *(const u32x2*)pp;
        if (CONV) { r.xm[k] = *(const u32x2*)(pp - (t > 0 ? ldp : 0)); r.xp[k] = *(const u32x2*)(pp + (t < len - 1 ? ldp : 0)); }
    }
}
template <bool CONV, int NI>
__device__ __forceinline__ f32x4 stage_value(const StageRaw<CONV, NI>& r, int k, int i, int ch, int len, int c0, int d, const float* scw, const float* scb) {
    constexpr int NCH = NI * 32;
    const u32x2 x0 = r.x0[k];
    const f32x4 f0 = (f32x4){lo16(x0.x), hi16(x0.x), lo16(x0.y), hi16(x0.y)};
    if (!CONV) return f0;
    const int pi = c0 + i, t = d ? (len - 1 - pi) : pi;
    const bool mok = (t > 0), pok = (t < len - 1);
    const u32x2 xm = r.xm[k], xp = r.xp[k];
    const f32x4 fm = mok ? (f32x4){lo16(xm.x), hi16(xm.x), lo16(xm.y), hi16(xm.y)} : (f32x4){0.f, 0.f, 0.f, 0.f};
    const f32x4 fp = pok ? (f32x4){lo16(xp.x), hi16(xp.x), lo16(xp.y), hi16(xp.y)} : (f32x4){0.f, 0.f, 0.f, 0.f};
    f32x4 v = *(const f32x4*)(scb + ch) + *(const f32x4*)(scw + ch) * fm + *(const f32x4*)(scw + NCH + ch) * f0 + *(const f32x4*)(scw + 2 * NCH + ch) * fp;
    v[0] = siluf_(v[0]); v[1] = siluf_(v[1]); v[2] = siluf_(v[2]); v[3] = siluf_(v[3]);
    return v;
}
template <bool CONV, int NI>
__device__ __forceinline__ void stage_store(const StageRaw<CONV, NI>& r, int len, int c0, int d, const float* scw, const float* scb, float* srow, int tid_) {
    constexpr int NQ = NI * 8, NCH = NI * 32;
    asm volatile("" : "+v"(tid_));
#pragma unroll
    for (int k = 0; k < NI; ++k) {
        const int it = tid_ + k * NTHR, i = it / NQ, ch = (it % NQ) * 4;
        *(f32x4*)(srow + i * NCH + ch) = stage_value<CONV, NI>(r, k, i, ch, len, c0, d, scw, scb);
    }
}

__device__ void scan_ssd(CP& p, unsigned char* shm, int id) {
    OPQ_IDS;
    const int tid = tid_;
    const int b = id / 48, rem = id % 48, h = rem >> 1, d = rem & 1, g = h / 6;
    float* srow = (float*)shm;
    float* scw = srow + 64 * 320;
    float* scb = scw + 3 * 320;
    float* sdt = scb + 320;
    float* sdec = sdt + 64;
    float* sout = sdec + 64;
    const bf16_t* proj = (const bf16_t*)(p.ws + WS_BIG);
    const float* gates = (const float*)(p.ws + WS_GATES);
    bf16_t* yd = (bf16_t*)(p.ws + WS_BIG + BIG_PROJ) + (size_t)d * MTOT * DM;
    auto colmap = [=](int ch) { return ch < 64 ? (2048 + h * 64 + ch) : (ch < 192 ? (3584 + g * 128 + (ch - 64)) : (4096 + g * 128 + (ch - 192))); };
    for (int e = tid; e < 320; e += NTHR) { const int cc = colmap(e) - 2048;
        scw[e] = p.in[23][cc]; scw[320 + e] = p.in[23][2560 + cc]; scw[640 + e] = p.in[23][2 * 2560 + cc]; scb[e] = p.in[24][cc]; }
    const float dtb = p.in[25][d * 24 + h], aneg = -expf(p.in[26][d * 24 + h]);
    const int ns = tid & 15, pp = tid >> 4;
    float s0[8], s1[8];
#pragma unroll
    for (int j = 0; j < 8; ++j) { s0[j] = 0.f; s1[j] = 0.f; }
    __syncthreads();
    StageRaw<true, 10> raw; float graw = 0.f;
    { int len, rowbase, c0; chunk_pos(0, b, len, rowbase, c0); stage_load<true, 10>(raw, proj, NE_MAIN, rowbase, len, c0, d, colmap, tid_);
      if (tid_ < 64) { const int pi = c0 + tid_, t = d ? (len - 1 - pi) : pi; graw = gates[(size_t)(rowbase + t) * 64 + d * 24 + h]; } }
    for (int cidx = 0; cidx < 68; ++cidx) {
        int len, rowbase, c0; chunk_pos(cidx, b, len, rowbase, c0);
        {
            stage_store<true, 10>(raw, len, c0, d, scw, scb, srow, tid_);
            if (tid_ < 64) { const float dt = softplusf_(graw + dtb); sdt[tid_] = dt; sdec[tid_] = expf(dt * aneg); }
            __syncthreads();
            if (cidx + 1 < 68) { int len2, rowbase2, c02; chunk_pos(cidx + 1, b, len2, rowbase2, c02); stage_load<true, 10>(raw, proj, NE_MAIN, rowbase2, len2, c02, d, colmap, tid_);
                if (tid_ < 64) { const int pi = c02 + tid_, t = d ? (len2 - 1 - pi) : pi; graw = gates[(size_t)(rowbase2 + t) * 64 + d * 24 + h]; } }
            {
                const float* rp0 = srow;
                float dec_n = sdec[0], dtv_n = sdt[0]; float2 xv_n = *(const float2*)(rp0 + 2 * pp);
                f32x4 B0n = *(const f32x4*)(rp0 + 64 + ns * 8), B1n = *(const f32x4*)(rp0 + 64 + ns * 8 + 4), C0n = *(const f32x4*)(rp0 + 192 + ns * 8), C1n = *(const f32x4*)(rp0 + 192 + ns * 8 + 4);
                for (int i = 0; i < 64; ++i) {
                    const float dec = dec_n, dtv = dtv_n; const float2 xv = xv_n; const f32x4 B0 = B0n, B1 = B1n, C0 = C0n, C1 = C1n;
                    if (i < 63) { const float* rp = srow + (i + 1) * 320; dec_n = sdec[i + 1]; dtv_n = sdt[i + 1]; xv_n = *(const float2*)(rp + 2 * pp);
                        B0n = *(const f32x4*)(rp + 64 + ns * 8); B1n = *(const f32x4*)(rp + 64 + ns * 8 + 4); C0n = *(const f32x4*)(rp + 192 + ns * 8); C1n = *(const f32x4*)(rp + 192 + ns * 8 + 4); }
                    const float x0 = xv.x * dtv, x1 = xv.y * dtv;
                    float y0a = 0.f, y0b = 0.f, y1a = 0.f, y1b = 0.f;
#pragma unroll
                    for (int j = 0; j < 4; ++j) {
                        s0[j] = s0[j] * dec + x0 * B0[j]; s1[j] = s1[j] * dec + x1 * B0[j]; y0a += s0[j] * C0[j]; y1a += s1[j] * C0[j];
                        s0[4 + j] = s0[4 + j] * dec + x0 * B1[j]; s1[4 + j] = s1[4 + j] * dec + x1 * B1[j]; y0b += s0[4 + j] * C1[j]; y1b += s1[4 + j] * C1[j]; }
                    const float y0 = red16(y0a + y0b), y1 = red16(y1a + y1b);
                    if (ns == 0) *(float2*)(sout + i * 64 + 2 * pp) = make_float2(y0, y1);
                }
            }
            __syncthreads();
            { const int i = tid_ >> 3, c8 = (tid_ & 7) * 8, pi = c0 + i, t = d ? (len - 1 - pi) : pi; float o[8]; ldf8(sout + i * 64 + c8, o);
              st8(yd + (size_t)(rowbase + t) * DM + 512 + h * 64 + c8, o); }
        }
    }
}

__device__ void scan_s5(CP& p, unsigned char* shm, int id2) {
    OPQ_IDS;
    const int tid = tid_, sl = tid >> 7, j = tid & 127, st = j >> 1, part = j & 1;
    const int s = id2 * 4 + sl, b = s >> 6, rem = s & 63, g = rem >> 1, d = rem & 1;
    float* su = (float*)shm + sl * (32 * 16);
    float* sX = (float*)shm + 4 * 32 * 16 + sl * (32 * 132);
    float* sC = (float*)shm + 4 * 32 * 16 + 4 * 32 * 132 + sl * (128 * 16);
    const bf16_t* proj = (const bf16_t*)(p.ws + WS_BIG);
    bf16_t* yd = (bf16_t*)(p.ws + WS_BIG + BIG_PROJ) + (size_t)d * MTOT * DM;
    const int dg = d * 32 + g;
    const float lr = p.in[14][dg * 64 + st], li = p.in[15][dg * 64 + st], step = expf(p.in[16][dg]);
    const float ea = lr * step, eb = li * step, mag = expf(ea), cb = cosf(eb), sb = sinf(eb), shb = sinf(0.5f * eb);
    const float lbr = mag * cb, lbi = mag * sb;
    const float nr = expm1f(ea) * cb - 2.f * shb * shb, ni = lbi;
    const float den = lr * lr + li * li;
    const float qr = (nr * lr + ni * li) / den, qi = (ni * lr - nr * li) / den;
    float Bb[16];
#pragma unroll
    for (int hh = 0; hh < 16; ++hh) { const float br = p.in[17][(size_t)(dg * 64 + st) * 16 + hh], bi = p.in[18][(size_t)(dg * 64 + st) * 16 + hh];
        Bb[hh] = part ? (qr * bi + qi * br) : (qr * br - qi * bi); }
#pragma unroll
    for (int hh = 0; hh < 16; ++hh) sC[j * 16 + hh] = part ? -p.in[20][(size_t)(dg * 16 + hh) * 64 + st] : p.in[19][(size_t)(dg * 16 + hh) * 64 + st];
    const float lis = part ? lbi : -lbi;
    float x = 0.f;
    __syncthreads();
    for (int seg = 0; seg < 2; ++seg) {
        const int len = seg_len(seg), rowbase = seg_base(seg, b);
        for (int c0 = 0; c0 < len; c0 += 32) {
            { const int i = j >> 2, hq = j & 3, pi = c0 + i, t = d ? (len - 1 - pi) : pi;
              const u32x2 raw = *(const u32x2*)(proj + (size_t)(rowbase + t) * NE_MAIN + g * 16 + hq * 4);
              *(f32x4*)(su + i * 16 + hq * 4) = (f32x4){lo16(raw.x), hi16(raw.x), lo16(raw.y), hi16(raw.y)}; }
            __syncthreads();
            for (int i = 0; i < 32; ++i) {
                const f32x4 u0 = *(const f32x4*)(su + i * 16), u1 = *(const f32x4*)(su + i * 16 + 4), u2 = *(const f32x4*)(su + i * 16 + 8), u3 = *(const f32x4*)(su + i * 16 + 12);
                float bu = 0.f;
#pragma unroll
                for (int q = 0; q < 4; ++q) bu += Bb[q] * u0[q] + Bb[4 + q] * u1[q] + Bb[8 + q] * u2[q] + Bb[12 + q] * u3[q];
                const float xp = dppmov<0xB1>(x);
                x = lbr * x + lis * xp + bu;
                sX[i * 132 + j] = x;
            }
            __syncthreads();
            { const int i = j >> 2, hq = j & 3, pi = c0 + i, t = d ? (len - 1 - pi) : pi;
              f32x4 acc = (f32x4){0.f, 0.f, 0.f, 0.f};
              for (int jj = 0; jj < 128; jj += 4) { const f32x4 xv = *(const f32x4*)(sX + i * 132 + jj);
#pragma unroll
                  for (int q = 0; q < 4; ++q) acc += *(const f32x4*)(sC + (jj + q) * 16 + hq * 4) * xv[q]; }
              u32x2 o; o.x = pack2(acc[0], acc[1]); o.y = pack2(acc[2], acc[3]);
              *(u32x2*)(yd + (size_t)(rowbase + t) * DM + g * 16 + hq * 4) = o; }
        }
    }
}

__device__ void scan_gdn(CP& p, unsigned char* shm, int id) {
    OPQ_IDS;
    const int tid = tid_, lane = tid & 63, wid = tid >> 6;
    const int b = id >> 5, rem = id & 31, h = rem >> 2, d = (rem >> 1) & 1, vh = rem & 1;
    float* srow = (float*)shm;
    float* scw = srow + 64 * 320;
    float* scb = scw + 3 * 320;
    float* srq = scb + 320;
    float* srk = srq + 64;
    float* sa = srk + 64;
    float* sbt = sa + 64;
    float* sout = sbt + 64;
    const bf16_t* proj = (const bf16_t*)(p.ws + WS_BIG);
    const float* gates = (const float*)(p.ws + WS_GATES);
    bf16_t* yd = (bf16_t*)(p.ws + WS_BIG + BIG_PROJ) + (size_t)d * MTOT * DM;
    auto colmap = [=](int ch) { return ch < 128 ? (h * 128 + ch) : (ch < 256 ? (1024 + h * 128 + (ch - 128)) : (2048 + h * 128 + vh * 64 + (ch - 256))); };
    for (int e = tid; e < 320; e += NTHR) { const int cc = colmap(e);
        scw[e] = p.in[31][cc]; scw[320 + e] = p.in[31][3072 + cc]; scw[640 + e] = p.in[31][2 * 3072 + cc]; scb[e] = 0.f; }
    const float dtb = p.in[32][d * 8 + h], aexp = -expf(p.in[33][d * 8 + h]);
    const int ks = tid & 7, col = tid >> 3;
    float S[16];
#pragma unroll
    for (int jx = 0; jx < 16; ++jx) S[jx] = 0.f;
    __syncthreads();
    StageRaw<true, 10> raw; float graw0 = 0.f, graw1 = 0.f;
    { int len, rowbase, c0; chunk_pos(0, b, len, rowbase, c0); stage_load<true, 10>(raw, proj, NO_MAIN, rowbase, len, c0, d, colmap, tid_);
      if (tid_ < 64) { const int pi = c0 + tid_, t = d ? (len - 1 - pi) : pi; const float* gp = gates + (size_t)(rowbase + t) * 64; graw0 = gp[d * 8 + h]; graw1 = gp[16 + d * 8 + h]; } }
    for (int cidx = 0; cidx < 68; ++cidx) {
        int len, rowbase, c0; chunk_pos(cidx, b, len, rowbase, c0);
        {
            stage_store<true, 10>(raw, len, c0, d, scw, scb, srow, tid_);
            if (tid_ < 64) { sbt[tid_] = sigmoidf_(graw0); sa[tid_] = expf(aexp * softplusf_(graw1 + dtb)); }
            __syncthreads();
            if (cidx + 1 < 68) { int len2, rowbase2, c02; chunk_pos(cidx + 1, b, len2, rowbase2, c02); stage_load<true, 10>(raw, proj, NO_MAIN, rowbase2, len2, c02, d, colmap, tid_);
                if (tid_ < 64) { const int pi = c02 + tid_, t = d ? (len2 - 1 - pi) : pi; const float* gp = gates + (size_t)(rowbase2 + t) * 64; graw0 = gp[d * 8 + h]; graw1 = gp[16 + d * 8 + h]; } }
            for (int i = wid; i < 64; i += 8) { const float* rp = srow + i * 320;
                float q2 = rp[lane] * rp[lane] + rp[64 + lane] * rp[64 + lane], k2 = rp[128 + lane] * rp[128 + lane] + rp[192 + lane] * rp[192 + lane];
                q2 = red64(q2); k2 = red64(k2);
                if (lane == 0) { srq[i] = rsqrtf(q2 + 1e-6f) * 0.08838834764831845f; srk[i] = rsqrtf(k2 + 1e-6f); } }
            __syncthreads();
            {
                float a_n = sa[0], bt_n = sbt[0], rk_n = srk[0], rq_n = srq[0], vv_n = srow[256 + col];
                f32x4 kkn[4], qqn[4];
#pragma unroll
                for (int q = 0; q < 4; ++q) { kkn[q] = *(const f32x4*)(srow + 128 + ks * 16 + q * 4); qqn[q] = *(const f32x4*)(srow + ks * 16 + q * 4); }
                for (int i = 0; i < 64; ++i) {
                    const float a = a_n, bt = bt_n, rk = rk_n, rq = rq_n, vv = vv_n;
                    f32x4 kk[4], qq[4];
#pragma unroll
                    for (int q = 0; q < 4; ++q) { kk[q] = kkn[q]; qq[q] = qqn[q]; }
                    if (i < 63) { const float* rp = srow + (i + 1) * 320; a_n = sa[i + 1]; bt_n = sbt[i + 1]; rk_n = srk[i + 1]; rq_n = srq[i + 1]; vv_n = rp[256 + col];
#pragma unroll
                        for (int q = 0; q < 4; ++q) { kkn[q] = *(const f32x4*)(rp + 128 + ks * 16 + q * 4); qqn[q] = *(const f32x4*)(rp + ks * 16 + q * 4); } }
                    float dq[4];
#pragma unroll
                    for (int q = 0; q < 4; ++q) dq[q] = kk[q][0] * S[q * 4] + kk[q][1] * S[q * 4 + 1] + kk[q][2] * S[q * 4 + 2] + kk[q][3] * S[q * 4 + 3];
                    const float dd = red8((dq[0] + dq[1]) + (dq[2] + dq[3])) * rk;
                    const float w = bt * (vv - a * dd) * rk;
                    float oq[4];
#pragma unroll
                    for (int q = 0; q < 4; ++q) {
#pragma unroll
                        for (int e = 0; e < 4; ++e) S[q * 4 + e] = a * S[q * 4 + e] + kk[q][e] * w;
                        oq[q] = qq[q][0] * S[q * 4] + qq[q][1] * S[q * 4 + 1] + qq[q][2] * S[q * 4 + 2] + qq[q][3] * S[q * 4 + 3]; }
                    const float o = red8((oq[0] + oq[1]) + (oq[2] + oq[3])) * rq;
                    if (ks == 0) sout[i * 64 + col] = o;
                }
            }
            __syncthreads();
            { const int i = tid_ >> 3, c8 = (tid_ & 7) * 8, pi = c0 + i, t = d ? (len - 1 - pi) : pi; float o[8]; ldf8(sout + i * 64 + c8, o);
              st8(yd + (size_t)(rowbase + t) * DM + h * 128 + vh * 64 + c8, o); }
        }
    }
}

__device__ void scan_mlstm(CP& p, unsigned char* shm, int id) {
    OPQ_IDS;
    const int tid = tid_, lane = tid & 63, wid = tid >> 6;
    const int b = id >> 5, rem = id & 31, h = rem >> 3, d = (rem >> 2) & 1, vq = rem & 3;
    float* srow = (float*)shm;
    float* sf = srow + 64 * 320;
    float* se = sf + 64;
    float* sout = se + 64;
    float* sden = sout + 64 * 64;
    const bf16_t* proj = (const bf16_t*)(p.ws + WS_BIG);
    const float* gates = (const float*)(p.ws + WS_GATES);
    bf16_t* yd = (bf16_t*)(p.ws + WS_BIG + BIG_PROJ) + (size_t)d * MTOT * DM;
    float* den = (float*)(p.ws + WS_DEN) + (size_t)d * MTOT * 4;
    auto colmap = [=](int ch) { return ch < 128 ? (4096 + h * 128 + ch) : (ch < 256 ? (4608 + h * 128 + (ch - 128)) : (5120 + h * 256 + vq * 64 + (ch - 256))); };
    const float ib = p.in[35][d * 4 + h], fb = p.in[36][d * 4 + h];
    const int ks = tid & 7, col = tid >> 3;
    const bool do_den = (vq == 0) && (wid == 0);
    float C[16];
#pragma unroll
    for (int jx = 0; jx < 16; ++jx) C[jx] = 0.f;
    float n0 = 0.f, n1 = 0.f;
    const float ksc = 0.08838834764831845f;
    StageRaw<false, 10> raw; float graw0 = 0.f, graw1 = 0.f;
    { int len, rowbase, c0; chunk_pos(0, b, len, rowbase, c0); stage_load<false, 10>(raw, proj, NO_MAIN, rowbase, len, c0, d, colmap, tid_);
      if (tid_ < 64) { const int pi = c0 + tid_, t = d ? (len - 1 - pi) : pi; const float* gp = gates + (size_t)(rowbase + t) * 64; graw0 = gp[32 + d * 4 + h]; graw1 = gp[40 + d * 4 + h]; } }
    for (int cidx = 0; cidx < 68; ++cidx) {
        int len, rowbase, c0; chunk_pos(cidx, b, len, rowbase, c0);
        {
            stage_store<false, 10>(raw, len, c0, d, (const float*)nullptr, (const float*)nullptr, srow, tid_);
            if (tid_ < 64) { se[tid_] = expf(graw0 + ib); sf[tid_] = sigmoidf_(graw1 + fb); }
            __syncthreads();
            if (cidx + 1 < 68) { int len2, rowbase2, c02; chunk_pos(cidx + 1, b, len2, rowbase2, c02); stage_load<false, 10>(raw, proj, NO_MAIN, rowbase2, len2, c02, d, colmap, tid_);
                if (tid_ < 64) { const int pi = c02 + tid_, t = d ? (len2 - 1 - pi) : pi; const float* gp = gates + (size_t)(rowbase2 + t) * 64; graw0 = gp[32 + d * 4 + h]; graw1 = gp[40 + d * 4 + h]; } }
            {
                float f_n = sf[0], ei_n = se[0] * ksc, vv_n = srow[256 + col];
                f32x4 kkn[4], qqn[4];
#pragma unroll
                for (int q = 0; q < 4; ++q) { kkn[q] = *(const f32x4*)(srow + 128 + ks * 16 + q * 4); qqn[q] = *(const f32x4*)(srow + ks * 16 + q * 4); }
                for (int i = 0; i < 64; ++i) {
                    const float f = f_n, ei = ei_n, vv = vv_n;
                    f32x4 kk[4], qq[4];
#pragma unroll
                    for (int q = 0; q < 4; ++q) { kk[q] = kkn[q]; qq[q] = qqn[q]; }
                    const float* rpc = srow + i * 320;
                    if (i < 63) { const float* rp = srow + (i + 1) * 320; f_n = sf[i + 1]; ei_n = se[i + 1] * ksc; vv_n = rp[256 + col];
#pragma unroll
                        for (int q = 0; q < 4; ++q) { kkn[q] = *(const f32x4*)(rp + 128 + ks * 16 + q * 4); qqn[q] = *(const f32x4*)(rp + ks * 16 + q * 4); } }
                    const float w = ei * vv;
                    float oq[4];
#pragma unroll
                    for (int q = 0; q < 4; ++q) {
#pragma unroll
                        for (int e = 0; e < 4; ++e) C[q * 4 + e] = f * C[q * 4 + e] + kk[q][e] * w;
                        oq[q] = qq[q][0] * C[q * 4] + qq[q][1] * C[q * 4 + 1] + qq[q][2] * C[q * 4 + 2] + qq[q][3] * C[q * 4 + 3]; }
                    const float o = red8((oq[0] + oq[1]) + (oq[2] + oq[3]));
                    if (ks == 0) sout[i * 64 + col] = o;
                    if (do_den) {
                        const float2 k2 = *(const float2*)(rpc + 128 + 2 * lane), q2 = *(const float2*)(rpc + 2 * lane);
                        n0 = f * n0 + ei * k2.x; n1 = f * n1 + ei * k2.y;
                        float dn = q2.x * n0 + q2.y * n1;
                        dn = red64(dn);
                        if (lane == 0) sden[i] = dn;
                    }
                }
            }
            __syncthreads();
            { const int i = tid_ >> 3, c8 = (tid_ & 7) * 8, pi = c0 + i, t = d ? (len - 1 - pi) : pi; float o[8]; ldf8(sout + i * 64 + c8, o);
              st8(yd + (size_t)(rowbase + t) * DM + 1024 + h * 256 + vq * 64 + c8, o);
              if (vq == 0 && tid_ < 64) { const int pj = c0 + tid_, tj = d ? (len - 1 - pj) : pj; den[(size_t)(rowbase + tj) * 4 + h] = sden[tid_]; } }
        }
    }
}

constexpr int LQ = 136, LT = 72, PV = 88;
typedef short s16x4 __attribute__((ext_vector_type(4)));
__device__ __forceinline__ bf16x8 ldfrag(const bf16_t* base, int row0, int ks, int ld, int fr, int fq) { return *(const bf16x8*)(base + (row0 + fr) * ld + ks * 32 + fq * 8); }
__device__ __forceinline__ bf16x8 ldfrag_tr(const bf16_t* base, int krow0, int col0, int ld, int fr) {
    const bf16_t* a = base + (krow0 + (fr >> 2)) * ld + col0 + (fr & 3) * 4;
    const s16x4 lo = __builtin_amdgcn_ds_read_tr16_b64_v4i16((LAS s16x4*)a);
    const s16x4 hi = __builtin_amdgcn_ds_read_tr16_b64_v4i16((LAS s16x4*)(a + 4 * ld));
    return (bf16x8){lo[0], lo[1], lo[2], lo[3], hi[0], hi[1], hi[2], hi[3]};
}
__device__ __forceinline__ float softplus_fast(float x) { return fmaxf(x, 0.f) + __logf(1.f + __expf(-fabsf(x))); }
struct SsdRaw { u32x2 x0[2], xm[2], xp[2], bc[8]; };
__device__ __forceinline__ void ssd_load(SsdRaw& r, const bf16_t* proj, const bf16_t* bcbuf, int rowbase, int len, int c0, int d, int h, int g, int tid_) {
    asm volatile("" : "+v"(tid_));
#pragma unroll
    for (int k = 0; k < 2; ++k) { const int it = tid_ + k * NTHR, i = it >> 4, ch = (it & 15) * 4, pi = c0 + i, t = d ? (len - 1 - pi) : pi;
        const bf16_t* pp = proj + (size_t)(rowbase + t) * NE_MAIN + 2048 + h * 64 + ch;
        r.x0[k] = *(const u32x2*)pp; r.xm[k] = *(const u32x2*)(pp - (t > 0 ? NE_MAIN : 0)); r.xp[k] = *(const u32x2*)(pp + (t < len - 1 ? NE_MAIN : 0)); }
#pragma unroll
    for (int k = 0; k < 8; ++k) { const int it = tid_ + k * NTHR, i = it >> 6, ch = (it & 63) * 4, pi = c0 + i, t = d ? (len - 1 - pi) : pi;
        r.bc[k] = *(const u32x2*)(bcbuf + (size_t)(rowbase + t) * 1024 + (ch < 128 ? (g * 128 + ch) : (512 + g * 128 + (ch - 128)))); }
}
__device__ void ssd_bc_prepass(CP& p) {
    OPQ_IDS;
    const int lane = tid_ & 63, wid = tid_ >> 6;
    const bf16_t* proj = (const bf16_t*)(p.ws + WS_BIG); bf16_t* bc = (bf16_t*)(p.ws + WS_ACT);
    for (int row = bid_ * 8 + wid; row < MTOT; row += gridDim.x * 8) {
        int t, len;
        if (row < MLAT) { t = row & (SEQ - 1); len = SEQ; } else { t = (row - MLAT) & (CTXL - 1); len = CTXL; }
        const bf16_t* pr = proj + (size_t)row * NE_MAIN + 3584;
#pragma unroll
        for (int ps = 0; ps < 2; ++ps) { const int c = ps * 512 + lane * 8, cc = 1536 + c;
            float x0[8], xm[8], xp[8], w0[8], w1[8], w2[8], cb[8], o[8];
            ld8(pr + c, x0);
            if (t > 0) ld8(pr - NE_MAIN + c, xm); else { for (int q = 0; q < 8; ++q) xm[q] = 0.f; }
            if (t < len - 1) ld8(pr + NE_MAIN + c, xp); else { for (int q = 0; q < 8; ++q) xp[q] = 0.f; }
            ldf8(p.in[23] + cc, w0); ldf8(p.in[23] + 2560 + cc, w1); ldf8(p.in[23] + 5120 + cc, w2); ldf8(p.in[24] + cc, cb);
#pragma unroll
            for (int q = 0; q < 8; ++q) o[q] = siluf_(cb[q] + w0[q] * xm[q] + w1[q] * x0[q] + w2[q] * xp[q]);
            st8(bc + (size_t)row * 1024 + c, o); }
    }
}
template <int NVT, bool IS_SSD, int VW>
__device__ void scan_la(CP& p, unsigned char* shm, int id) {
    OPQ_IDS;
    const int lane = tid_ & 63, wid = tid_ >> 6, fr = lane & 15, fq = lane >> 4;
    int b, h, d, g = 0, vq = 0;
    if (IS_SSD) { b = id / 48; const int rem = id % 48; h = rem >> 1; d = rem & 1; g = h / 6; }
    else if (VW == 64) { b = id >> 5; const int rem = id & 31; h = rem >> 3; d = (rem >> 2) & 1; vq = rem & 3; }
    else { b = id >> 6; const int rem = id & 63; h = rem >> 4; d = (rem >> 3) & 1; vq = rem & 7; }
    bf16_t* sQ = (bf16_t*)shm;
    bf16_t* sK = sQ + 64 * LQ;
    bf16_t* sV = sK + 64 * LQ;
    bf16_t* sVw = sV + 64 * PV;
    bf16_t* sP = sVw + 64 * PV;
    bf16_t* sS = sP + 64 * LT;
    float* sout = (float*)(sS + 80 * LQ);
    float* scw = sout + 4096;
    float* scb = scw + 960;
    float* scum = scb + 320;
    float* sw = scum + 64;
    float* se = sw + 64;
    float* sden = se + 64;
    const bf16_t* proj = (const bf16_t*)(p.ws + WS_BIG);
    const float* gates = (const float*)(p.ws + WS_GATES);
    bf16_t* yd = (bf16_t*)(p.ws + WS_BIG + BIG_PROJ) + (size_t)d * MTOT * DM;
    float* den = (float*)(p.ws + WS_DEN) + (size_t)d * MTOT * 4;
    const int ldp = IS_SSD ? NE_MAIN : NO_MAIN;
    auto colmap = [=](int ch) { return IS_SSD ? (ch < 64 ? (2048 + h * 64 + ch) : (ch < 192 ? (3584 + g * 128 + (ch - 64)) : (4096 + g * 128 + (ch - 192))))
                                              : (ch < VW ? (5120 + h * 256 + vq * VW + ch) : (ch < VW + 128 ? (4608 + h * 128 + (ch - VW)) : (4096 + h * 128 + (ch - VW - 128)))); };
    if (IS_SSD) for (int e = tid_; e < 320; e += NTHR) { const int cc = colmap(e) - 2048;
        scw[e] = p.in[23][cc]; scw[320 + e] = p.in[23][2560 + cc]; scw[640 + e] = p.in[23][2 * 2560 + cc]; scb[e] = p.in[24][cc]; }
    for (int e = tid_; e < 80 * LQ; e += NTHR) sS[e] = 0;
    for (int e = tid_; e < 64 * 24; e += NTHR) { const int i = e / 24, c = VW + e % 24; sV[i * PV + c] = (c == VW) ? (bf16_t)0x3F80 : (bf16_t)0; sVw[i * PV + c] = 0; }
    float g0b, g1b;
    if (IS_SSD) { g0b = p.in[25][d * 24 + h]; g1b = -expf(p.in[26][d * 24 + h]); }
    else { g0b = p.in[35][d * 4 + h]; g1b = p.in[36][d * 4 + h]; }
    const int gcol0 = IS_SSD ? (d * 24 + h) : (32 + d * 4 + h), gcol1 = IS_SSD ? (d * 24 + h) : (40 + d * 4 + h);
    f32x4 Sacc[NVT];
#pragma unroll
    for (int vt = 0; vt < NVT; ++vt) Sacc[vt] = (f32x4){0.f, 0.f, 0.f, 0.f};
    constexpr int NIM = (VW + 256) / 32;
    StageRaw<false, NIM> raw; SsdRaw sraw; float graw0 = 0.f, graw1 = 0.f;
    const bf16_t* bcbuf = (const bf16_t*)(p.ws + WS_ACT);
    static_assert(IS_SSD || (VW == 32 && NIM == 9), "mLSTM staging layout assumes 32-column v slices");
    const int mq_i0 = tid_ >> 6, mq_ch = (tid_ & 63) * 4;
    const int mq_col = (mq_ch < 128) ? (4608 + h * 128 + mq_ch) : (4096 + h * 128 + (mq_ch - 128));
    bf16_t* const mq_dst = (mq_ch < 128) ? (sK + mq_i0 * LQ + mq_ch) : (sQ + mq_i0 * LQ + (mq_ch - 128));
    const int mv_i = tid_ >> 3, mv_ch = (tid_ & 7) * 4, mv_col = 5120 + h * 256 + vq * VW + mv_ch;
    bf16_t* const mv_dst = sV + mv_i * PV + mv_ch;
    auto mload = [&](int rowbase_, int len_, int c0_) {
#pragma unroll
        for (int k = 0; k < 8; ++k) { const int pi = c0_ + mq_i0 + 8 * k, t = d ? (len_ - 1 - pi) : pi;
            raw.x0[k] = *(const u32x2*)(proj + (size_t)((rowbase_ + t) * ldp + mq_col)); }
        { const int pi = c0_ + mv_i, t = d ? (len_ - 1 - pi) : pi; raw.x0[8] = *(const u32x2*)(proj + (size_t)((rowbase_ + t) * ldp + mv_col)); }
    };
    const int sb_i0 = tid_ >> 6, sb_ch = (tid_ & 63) * 4, sb_col = (sb_ch < 128) ? (g * 128 + sb_ch) : (512 + g * 128 + (sb_ch - 128));
    bf16_t* const sb_dst = (sb_ch < 128) ? (sK + sb_i0 * LQ + sb_ch) : (sQ + sb_i0 * LQ + (sb_ch - 128));
    const int sx_i0 = tid_ >> 4, sx_ch = (tid_ & 15) * 4, sx_col = 2048 + h * 64 + sx_ch;
    bf16_t* const sx_dst = sV + sx_i0 * PV + sx_ch;
    auto sload = [&](int rowbase_, int len_, int c0_) {
#pragma unroll
        for (int k = 0; k < 2; ++k) { const int pi = c0_ + sx_i0 + 32 * k, t = d ? (len_ - 1 - pi) : pi;
            const bf16_t* pp = proj + (size_t)((rowbase_ + t) * NE_MAIN + sx_col);
            sraw.x0[k] = *(const u32x2*)pp; sraw.xm[k] = *(const u32x2*)(pp - (t > 0 ? NE_MAIN : 0)); sraw.xp[k] = *(const u32x2*)(pp + (t < len_ - 1 ? NE_MAIN : 0)); }
#pragma unroll
        for (int k = 0; k < 8; ++k) { const int pi = c0_ + sb_i0 + 8 * k, t = d ? (len_ - 1 - pi) : pi;
            sraw.bc[k] = *(const u32x2*)(bcbuf + (size_t)((rowbase_ + t) * 1024 + sb_col)); }
    };
    { int len, rowbase, c0; chunk_pos(0, b, len, rowbase, c0);
      if (IS_SSD) sload(rowbase, len, c0); else mload(rowbase, len, c0);
      if (tid_ < 64) { const int pi = c0 + tid_, t = d ? (len - 1 - pi) : pi; const float* gp = gates + (size_t)(rowbase + t) * 64; graw0 = gp[gcol0]; graw1 = gp[gcol1]; } }
    __syncthreads();
    const int rt = wid & 3, wh = wid >> 2;
    for (int cidx = 0; cidx < 68; ++cidx) {
        int len, rowbase, c0; chunk_pos(cidx, b, len, rowbase, c0);
        if (wid == 0) {
            float lf, e;
            if (IS_SSD) { const float dt = softplus_fast(graw0 + g0b); lf = dt * g1b; e = dt; }
            else { e = __expf(graw0 + g0b) * 0.08838834764831845f; lf = -softplus_fast(-(graw1 + g1b)); }
            float c = lf;
#pragma unroll
            for (int off = 1; off < 64; off <<= 1) { const float t2 = __shfl_up(c, off, 64); if (lane >= off) c += t2; }
            const float cend = __shfl(c, 63, 64);
            const float wj = e * __expf(cend - c);
            scum[lane] = c; se[lane] = e; sw[lane] = wj;
            if (!IS_SSD) sVw[lane * PV + VW] = f2bf(wj);
        }
        __syncthreads();
        if (IS_SSD) {
            const f32x4 cwb = *(const f32x4*)(scb + sx_ch), cwm = *(const f32x4*)(scw + sx_ch), cw0 = *(const f32x4*)(scw + 320 + sx_ch), cwp = *(const f32x4*)(scw + 640 + sx_ch);
#pragma unroll
            for (int k = 0; k < 2; ++k) {
                const int i = sx_i0 + 32 * k, pi = c0 + i, t = d ? (len - 1 - pi) : pi;
                const u32x2 x0 = sraw.x0[k], xm = sraw.xm[k], xp = sraw.xp[k];
                const f32x4 f0 = (f32x4){lo16(x0.x), hi16(x0.x), lo16(x0.y), hi16(x0.y)};
                const f32x4 fm = (t > 0) ? (f32x4){lo16(xm.x), hi16(xm.x), lo16(xm.y), hi16(xm.y)} : (f32x4){0.f, 0.f, 0.f, 0.f};
                const f32x4 fp = (t < len - 1) ? (f32x4){lo16(xp.x), hi16(xp.x), lo16(xp.y), hi16(xp.y)} : (f32x4){0.f, 0.f, 0.f, 0.f};
                f32x4 v = cwb + cwm * fm + cw0 * f0 + cwp * fp;
                v[0] = siluf_(v[0]); v[1] = siluf_(v[1]); v[2] = siluf_(v[2]); v[3] = siluf_(v[3]);
                const float wi = sw[i];
                u32x2 w2, w3; w2.x = pack2(v[0], v[1]); w2.y = pack2(v[2], v[3]); w3.x = pack2(v[0] * wi, v[1] * wi); w3.y = pack2(v[2] * wi, v[3] * wi);
                *(u32x2*)(sx_dst + k * 32 * PV) = w2; *(u32x2*)(sx_dst + k * 32 * PV + 64 * PV) = w3;
            }
#pragma unroll
            for (int k = 0; k < 8; ++k) *(u32x2*)(sb_dst + k * 8 * LQ) = sraw.bc[k];
        } else {
#pragma unroll
            for (int k = 0; k < 8; ++k) *(u32x2*)(mq_dst + k * 8 * LQ) = raw.x0[k];
            { const u32x2 w2 = raw.x0[8]; const float wi = sw[mv_i];
              u32x2 w3; w3.x = pack2(lo16(w2.x) * wi, hi16(w2.x) * wi); w3.y = pack2(lo16(w2.y) * wi, hi16(w2.y) * wi);
              *(u32x2*)mv_dst = w2; *(u32x2*)(mv_dst + 64 * PV) = w3; }
        }
        __syncthreads();
        if (cidx + 1 < 68) { int len2, rowbase2, c02; chunk_pos(cidx + 1, b, len2, rowbase2, c02);
            if (IS_SSD) sload(rowbase2, len2, c02); else mload(rowbase2, len2, c02);
            if (tid_ < 64) { const int pi = c02 + tid_, t = d ? (len2 - 1 - pi) : pi; const float* gp = gates + (size_t)(rowbase2 + t) * 64; graw0 = gp[gcol0]; graw1 = gp[gcol1]; } }
        const float cend = scum[63];
        bf16x8 aq[4];
#pragma unroll
        for (int ks = 0; ks < 4; ++ks) aq[ks] = ldfrag(sQ, rt * 16, ks, LQ, fr, fq);
#pragma unroll
        for (int c2 = 0; c2 < 2; ++c2) {
            const int ct = wh * 2 + c2;
            f32x4 pacc = (f32x4){0.f, 0.f, 0.f, 0.f};
#pragma unroll
            for (int ks = 0; ks < 4; ++ks) pacc = __builtin_amdgcn_mfma_f32_16x16x32_bf16(aq[ks], ldfrag(sK, ct * 16, ks, LQ, fr, fq), pacc, 0, 0, 0);
            const int jj = ct * 16 + fr; const float cj = scum[jj], ej = se[jj];
#pragma unroll
            for (int r = 0; r < 4; ++r) { const int ii = rt * 16 + fq * 4 + r;
                const float val = (jj <= ii) ? pacc[r] * __expf(scum[ii] - cj) * ej : 0.f;
                sP[ii * LT + jj] = f2bf(val); }
        }
        f32x4 oacc[3];
#pragma unroll
        for (int v3 = 0; v3 < 3; ++v3) {
            const int vt = wh + 2 * v3;
            oacc[v3] = (f32x4){0.f, 0.f, 0.f, 0.f};
            if (vt < NVT) {
#pragma unroll
                for (int ks = 0; ks < 4; ++ks) oacc[v3] = __builtin_amdgcn_mfma_f32_16x16x32_bf16(aq[ks], ldfrag(sS, vt * 16, ks, LQ, fr, fq), oacc[v3], 0, 0, 0);
#pragma unroll
                for (int r = 0; r < 4; ++r) oacc[v3][r] *= __expf(scum[rt * 16 + fq * 4 + r]);
            }
        }
        __syncthreads();
        {
            bf16x8 ap[2];
#pragma unroll
            for (int ks = 0; ks < 2; ++ks) ap[ks] = ldfrag(sP, rt * 16, ks, LT, fr, fq);
#pragma unroll
            for (int v3 = 0; v3 < 3; ++v3) {
                const int vt = wh + 2 * v3;
                if (vt < NVT) {
#pragma unroll
                    for (int ks = 0; ks < 2; ++ks) oacc[v3] = __builtin_amdgcn_mfma_f32_16x16x32_bf16(ap[ks], ldfrag_tr(sV, ks * 32 + fq * 8, vt * 16, PV, fr), oacc[v3], 0, 0, 0);
                    const int vv = vt * 16 + fr;
#pragma unroll
                    for (int r = 0; r < 4; ++r) { const int ii = rt * 16 + fq * 4 + r;
                        if (vv < VW) sout[ii * VW + vv] = oacc[v3][r]; else if (vv == VW) sden[ii] = oacc[v3][r]; }
                }
            }
        }
        {
            const float sc = __expf(cend);
            bf16x8 ak[2];
#pragma unroll
            for (int ks = 0; ks < 2; ++ks) ak[ks] = ldfrag_tr(sK, ks * 32 + fq * 8, wid * 16, LQ, fr);
#pragma unroll
            for (int vt = 0; vt < NVT; ++vt) {
                Sacc[vt] *= sc;
#pragma unroll
                for (int ks = 0; ks < 2; ++ks) Sacc[vt] = __builtin_amdgcn_mfma_f32_16x16x32_bf16(ak[ks], ldfrag_tr(sVw, ks * 32 + fq * 8, vt * 16, PV, fr), Sacc[vt], 0, 0, 0);
                u32x2 w2; w2.x = pack2(Sacc[vt][0], Sacc[vt][1]); w2.y = pack2(Sacc[vt][2], Sacc[vt][3]);
                *(u32x2*)(sS + (vt * 16 + fr) * LQ + wid * 16 + fq * 4) = w2;
            }
        }
        __syncthreads();
        { const int i = tid_ >> 3, c8 = (tid_ & 7) * 8, pi = c0 + i, t = d ? (len - 1 - pi) : pi; float o[8]; ldf8(sout + i * 64 + c8, o);
          if (IS_SSD) st8(yd + (size_t)(rowbase + t) * DM + 512 + h * 64 + c8, o);
          else if (VW == 64) { st8(yd + (size_t)(rowbase + t) * DM + 1024 + h * 256 + vq * 64 + c8, o);
                 if (vq == 0 && tid_ < 64) { const int pj = c0 + tid_, tj = d ? (len - 1 - pj) : pj; den[(size_t)(rowbase + tj) * 4 + h] = sden[tid_]; } }
          else { if (tid_ < 256) { const int i2 = tid_ >> 2, c82 = (tid_ & 3) * 8, pi2 = c0 + i2, t2 = d ? (len - 1 - pi2) : pi2; float o2[8]; ldf8(sout + i2 * 32 + c82, o2);
                     st8(yd + (size_t)(rowbase + t2) * DM + 1024 + h * 256 + vq * 32 + c82, o2); }
                 if (vq == 0 && tid_ < 64) { const int pj = c0 + tid_, tj = d ? (len - 1 - pj) : pj; den[(size_t)(rowbase + tj) * 4 + h] = sden[tid_]; } } }
    }
}

__device__ void gdn_qk_prepass(CP& p) {
    OPQ_IDS;
    const int lane = tid_ & 63, wid = tid_ >> 6;
    const bf16_t* proj = (const bf16_t*)(p.ws + WS_BIG); bf16_t* qk = (bf16_t*)(p.ws + WS_ACT);
    for (int row = bid_ * 8 + wid; row < MTOT; row += gridDim.x * 8) {
        int t, len;
        if (row < MLAT) { t = row & (SEQ - 1); len = SEQ; } else { t = (row - MLAT) & (CTXL - 1); len = CTXL; }
        const bf16_t* pr = proj + (size_t)row * NO_MAIN;
#pragma unroll
        for (int ps = 0; ps < 4; ++ps) { const int c = ps * 512 + lane * 8;
            float x0[8], xm[8], xp[8], w0[8], w1[8], w2[8], o[8];
            ld8(pr + c, x0);
            if (t > 0) ld8(pr - NO_MAIN + c, xm); else { for (int q = 0; q < 8; ++q) xm[q] = 0.f; }
            if (t < len - 1) ld8(pr + NO_MAIN + c, xp); else { for (int q = 0; q < 8; ++q) xp[q] = 0.f; }
            ldf8(p.in[31] + c, w0); ldf8(p.in[31] + 3072 + c, w1); ldf8(p.in[31] + 6144 + c, w2);
            float ss = 0.f;
#pragma unroll
            for (int q = 0; q < 8; ++q) { o[q] = siluf_(w0[q] * xm[q] + w1[q] * x0[q] + w2[q] * xp[q]); ss += o[q] * o[q]; }
            ss = red16(ss);
            const float rs = rsqrtf(ss + 1e-6f) * (ps < 2 ? 0.08838834764831845f : 1.f);
#pragma unroll
            for (int q = 0; q < 8; ++q) o[q] *= rs;
            st8(qk + (size_t)row * 2048 + c, o); }
    }
}
struct GdnRaw { u32x2 qk[8]; u32x2 v0, vm, vp; };
__device__ __forceinline__ void gdn_load(GdnRaw& r, const bf16_t* proj, const bf16_t* qkbuf, int rowbase, int len, int c0, int d, int h, int vqr, int tid_) {
    asm volatile("" : "+v"(tid_));
#pragma unroll
    for (int k = 0; k < 8; ++k) { const int it = tid_ + k * NTHR, i = it >> 6, ch = (it & 63) * 4, pi = c0 + i, t = d ? (len - 1 - pi) : pi;
        r.qk[k] = *(const u32x2*)(qkbuf + (size_t)(rowbase + t) * 2048 + (ch < 128 ? (h * 128 + ch) : (1024 + h * 128 + (ch - 128)))); }
    { const int i = tid_ >> 3, ch = (tid_ & 7) * 4, pi = c0 + i, t = d ? (len - 1 - pi) : pi;
      const bf16_t* pp = proj + (size_t)(rowbase + t) * NO_MAIN + 2048 + h * 128 + vqr * 32 + ch;
      r.v0 = *(const u32x2*)pp; r.vm = *(const u32x2*)(pp - (t > 0 ? NO_MAIN : 0)); r.vp = *(const u32x2*)(pp + (t < len - 1 ? NO_MAIN : 0)); }
}
__device__ void scan_gdn256(CP& p, unsigned char* shm, int id) {
    OPQ_IDS;
    const int tid = tid_, lane = tid & 63, wid = tid >> 6;
    const int b = id >> 6, rem = id & 63, h = rem >> 3, d = (rem >> 2) & 1, vqr = rem & 3;
    constexpr int NCH = 288, RS = 292;
    float* srow = (float*)shm;
    float* scw = srow + 64 * RS;
    float* scb = scw + 3 * NCH;
    float* sout = scb + NCH;
    const bf16_t* proj = (const bf16_t*)(p.ws + WS_BIG);
    const float* gates = (const float*)(p.ws + WS_GATES);
    bf16_t* yd = (bf16_t*)(p.ws + WS_BIG + BIG_PROJ) + (size_t)d * MTOT * DM;
    auto colmap = [=](int ch) { return ch < 128 ? (h * 128 + ch) : (ch < 256 ? (1024 + h * 128 + (ch - 128)) : (2048 + h * 128 + vqr * 32 + (ch - 256))); };
    for (int e = tid; e < NCH; e += NTHR) { const int cc = colmap(e);
        scw[e] = p.in[31][cc]; scw[NCH + e] = p.in[31][3072 + cc]; scw[2 * NCH + e] = p.in[31][2 * 3072 + cc]; scb[e] = 0.f; }
    const float dtb = p.in[32][d * 8 + h], aexp = -expf(p.in[33][d * 8 + h]);
    const int ks = tid & 15, col = tid >> 4;
    f32x2 S2[4];
#pragma unroll
    for (int jx = 0; jx < 4; ++jx) S2[jx] = (f32x2){0.f, 0.f};
    __syncthreads();
    GdnRaw raw; float graw0 = 0.f, graw1 = 0.f;
    const bf16_t* qkbuf = (const bf16_t*)(p.ws + WS_ACT);
    { int len, rowbase, c0; chunk_pos(0, b, len, rowbase, c0); gdn_load(raw, proj, qkbuf, rowbase, len, c0, d, h, vqr, tid_);
      if (tid_ < 64) { const int pi = c0 + tid_, t = d ? (len - 1 - pi) : pi; const float* gp = gates + (size_t)(rowbase + t) * 64; graw0 = gp[d * 8 + h]; graw1 = gp[16 + d * 8 + h]; } }
    for (int cidx = 0; cidx < 68; ++cidx) {
        int len, rowbase, c0; chunk_pos(cidx, b, len, rowbase, c0);
        {
            int tl = tid_; asm volatile("" : "+v"(tl));
#pragma unroll
            for (int k = 0; k < 8; ++k) { const int it = tl + k * NTHR, i = it >> 6, ch = (it & 63) * 4; const u32x2 x = raw.qk[k];
                *(f32x4*)(srow + i * RS + ch) = (f32x4){lo16(x.x), hi16(x.x), lo16(x.y), hi16(x.y)}; }
            { const int i = tl >> 3, ch = 256 + (tl & 7) * 4, pi = c0 + i, t = d ? (len - 1 - pi) : pi;
              const u32x2 x0 = raw.v0, xm = raw.vm, xp = raw.vp;
              const f32x4 f0 = (f32x4){lo16(x0.x), hi16(x0.x), lo16(x0.y), hi16(x0.y)};
              const f32x4 fm = (t > 0) ? (f32x4){lo16(xm.x), hi16(xm.x), lo16(xm.y), hi16(xm.y)} : (f32x4){0.f, 0.f, 0.f, 0.f};
              const f32x4 fp = (t < len - 1) ? (f32x4){lo16(xp.x), hi16(xp.x), lo16(xp.y), hi16(xp.y)} : (f32x4){0.f, 0.f, 0.f, 0.f};
              f32x4 v = *(const f32x4*)(scw + ch) * fm + *(const f32x4*)(scw + NCH + ch) * f0 + *(const f32x4*)(scw + 2 * NCH + ch) * fp;
              v[0] = siluf_(v[0]); v[1] = siluf_(v[1]); v[2] = siluf_(v[2]); v[3] = siluf_(v[3]);
              *(f32x4*)(srow + i * RS + ch) = v; }
        }
        if (tid_ < 64) { srow[tid_ * RS + 288] = expf(aexp * softplusf_(graw1 + dtb)); srow[tid_ * RS + 289] = sigmoidf_(graw0); }
        __syncthreads();
        if (cidx + 1 < 68) { int len2, rowbase2, c02; chunk_pos(cidx + 1, b, len2, rowbase2, c02); gdn_load(raw, proj, qkbuf, rowbase2, len2, c02, d, h, vqr, tid_);
            if (tid_ < 64) { const int pi = c02 + tid_, t = d ? (len2 - 1 - pi) : pi; const float* gp = gates + (size_t)(rowbase2 + t) * 64; graw0 = gp[d * 8 + h]; graw1 = gp[16 + d * 8 + h]; } }
        {
            float* r0 = srow + (2 * (wid * 4 + (lane >> 4))) * RS; const float* r1 = r0 + RS; const int o8 = (lane & 15) * 8;
            const f32x4 k0a = *(const f32x4*)(r0 + 128 + o8), k0b = *(const f32x4*)(r0 + 132 + o8), k1a = *(const f32x4*)(r1 + 128 + o8), k1b = *(const f32x4*)(r1 + 132 + o8), q0a = *(const f32x4*)(r0 + o8), q0b = *(const f32x4*)(r0 + 4 + o8);
            float gk = k1a[0] * k0a[0] + k1a[1] * k0a[1] + k1a[2] * k0a[2] + k1a[3] * k0a[3] + k1b[0] * k0b[0] + k1b[1] * k0b[1] + k1b[2] * k0b[2] + k1b[3] * k0b[3];
            float rq2 = q0a[0] * k0a[0] + q0a[1] * k0a[1] + q0a[2] * k0a[2] + q0a[3] * k0a[3] + q0b[0] * k0b[0] + q0b[1] * k0b[1] + q0b[2] * k0b[2] + q0b[3] * k0b[3];
            gk = red16(gk); rq2 = red16(rq2);
            if ((lane & 15) == 0) { r0[290] = gk; r0[291] = rq2; }
        }
        __syncthreads();
        {
            const float* rk_p = srow + ks * 8;
            const float* rv_p = srow + 256 + col;
            float* so_p = sout + col;
            for (int m = 0; m < 32; ++m) {
                const f32x4 q0a = *(const f32x4*)(rk_p), q0b = *(const f32x4*)(rk_p + 4), k0a = *(const f32x4*)(rk_p + 128), k0b = *(const f32x4*)(rk_p + 132);
                const f32x4 q1a = *(const f32x4*)(rk_p + RS), q1b = *(const f32x4*)(rk_p + RS + 4), k1a = *(const f32x4*)(rk_p + RS + 128), k1b = *(const f32x4*)(rk_p + RS + 132);
                const f32x4 t0 = *(const f32x4*)(srow + (2 * m) * RS + 288);
                const float2 t1 = *(const float2*)(srow + (2 * m + 1) * RS + 288);
                const float v0 = rv_p[0], v1 = rv_p[RS];
                const f32x2 k0[4] = {{k0a[0], k0a[1]}, {k0a[2], k0a[3]}, {k0b[0], k0b[1]}, {k0b[2], k0b[3]}};
                const f32x2 k1[4] = {{k1a[0], k1a[1]}, {k1a[2], k1a[3]}, {k1b[0], k1b[1]}, {k1b[2], k1b[3]}};
                const f32x2 q0[4] = {{q0a[0], q0a[1]}, {q0a[2], q0a[3]}, {q0b[0], q0b[1]}, {q0b[2], q0b[3]}};
                const f32x2 q1[4] = {{q1a[0], q1a[1]}, {q1a[2], q1a[3]}, {q1b[0], q1b[1]}, {q1b[2], q1b[3]}};
                f32x2 d2 = k0[0] * S2[0], e2 = k1[0] * S2[0], f2 = q0[0] * S2[0];
#pragma unroll
                for (int e = 1; e < 4; ++e) { d2 = k0[e] * S2[e] + d2; e2 = k1[e] * S2[e] + e2; f2 = q0[e] * S2[e] + f2; }
                float dd = d2[0] + d2[1], ee = e2[0] + e2[1], ff = f2[0] + f2[1];
                dd += dppmov<0xB1>(dd); ee += dppmov<0xB1>(ee); ff += dppmov<0xB1>(ff);
                dd += dppmov<0x4E>(dd); ee += dppmov<0x4E>(ee); ff += dppmov<0x4E>(ff);
                dd += dppmov<0x141>(dd); ee += dppmov<0x141>(ee); ff += dppmov<0x141>(ff);
                dd += dppmov<0x140>(dd); ee += dppmov<0x140>(ee); ff += dppmov<0x140>(ff);
                const float w0 = t0[1] * (v0 - t0[0] * dd);
                const float o0 = t0[0] * ff + t0[3] * w0;
                const float d1 = t0[0] * ee + t0[2] * w0;
                const float w1 = t1.y * (v1 - t1.x * d1);
                const float c0s = t1.x * t0[0], c1s = t1.x * w0;
#pragma unroll
                for (int e = 0; e < 4; ++e) S2[e] = S2[e] * c0s + k0[e] * c1s + k1[e] * w1;
                f32x2 o2 = q1[0] * S2[0];
#pragma unroll
                for (int e = 1; e < 4; ++e) o2 = q1[e] * S2[e] + o2;
                const float o1 = red16(o2[0] + o2[1]);
                if (ks == 0) { so_p[(2 * m) * 32] = o0; so_p[(2 * m + 1) * 32] = o1; }
                rk_p += 2 * RS; rv_p += 2 * RS;
            }
        }
        __syncthreads();
        if (tid_ < 256) { const int i = tid_ >> 2, c8 = (tid_ & 3) * 8, pi = c0 + i, t = d ? (len - 1 - pi) : pi; float o[8]; ldf8(sout + i * 32 + c8, o);
            st8(yd + (size_t)(rowbase + t) * DM + h * 128 + vqr * 32 + c8, o); }
    }
}

__device__ void scan_s5v2(CP& p, unsigned char* shm, int s) {
    OPQ_IDS;
    const int lane = tid_ & 63, wid = tid_ >> 6, fr = lane & 15, fq = lane >> 4;
    const int b = s >> 6, rem = s & 63, g = rem >> 1, d = rem & 1, dg = d * 32 + g;
    constexpr int LU = 40;
    bf16_t* sU = (bf16_t*)shm;
    bf16_t* sBb = sU + 64 * LU;
    bf16_t* sX = sBb + 128 * LU;
    bf16_t* sCm = sX + 64 * LQ;
    float* sBU = (float*)(sCm + 16 * LQ);
    const bf16_t* proj = (const bf16_t*)(p.ws + WS_BIG);
    bf16_t* yd = (bf16_t*)(p.ws + WS_BIG + BIG_PROJ) + (size_t)d * MTOT * DM;
    float lbr = 0.f, lis = 0.f;
    if (tid_ < 128) {
        const int j = tid_, st = j >> 1, part = j & 1;
        const float lr = p.in[14][dg * 64 + st], li = p.in[15][dg * 64 + st], step = expf(p.in[16][dg]);
        const float ea = lr * step, eb = li * step, mag = expf(ea), cb = cosf(eb), sb = sinf(eb), shb = sinf(0.5f * eb);
        lbr = mag * cb; const float lbi = mag * sb;
        const float nr = expm1f(ea) * cb - 2.f * shb * shb, ni = lbi;
        const float den = lr * lr + li * li;
        const float qr = (nr * lr + ni * li) / den, qi = (ni * lr - nr * li) / den;
        lis = part ? lbi : -lbi;
#pragma unroll
        for (int hh = 0; hh < 16; ++hh) { const float br = p.in[17][(size_t)(dg * 64 + st) * 16 + hh], bi = p.in[18][(size_t)(dg * 64 + st) * 16 + hh];
            const float v = part ? (qr * bi + qi * br) : (qr * br - qi * bi);
            const bf16_t hi = f2bf(v); const bf16_t lo = f2bf(v - bf2f(hi));
            sBb[j * LU + hh] = hi; sBb[j * LU + 16 + hh] = lo;
            sCm[hh * LQ + j] = f2bf(part ? -p.in[20][(size_t)(dg * 16 + hh) * 64 + st] : p.in[19][(size_t)(dg * 16 + hh) * 64 + st]); }
    }
    float x = 0.f;
    u32x2 uraw = (u32x2){0u, 0u};
    if (tid_ < 256) { int len, rowbase, c0; chunk_pos(0, b, len, rowbase, c0); const int i = tid_ >> 2, hq = tid_ & 3, pi = c0 + i, t = d ? (len - 1 - pi) : pi;
        uraw = *(const u32x2*)(proj + (size_t)(rowbase + t) * NE_MAIN + g * 16 + hq * 4); }
    __syncthreads();
    for (int cidx = 0; cidx < 68; ++cidx) {
        int len, rowbase, c0; chunk_pos(cidx, b, len, rowbase, c0);
        if (tid_ < 256) { const int i = tid_ >> 2, hq = tid_ & 3; *(u32x2*)(sU + i * LU + hq * 4) = uraw; *(u32x2*)(sU + i * LU + 16 + hq * 4) = uraw; }
        __syncthreads();
#pragma unroll
        for (int q = 0; q < 4; ++q) { const int tile = wid * 4 + q, tt = tile >> 3, jt = tile & 7;
            f32x4 acc = (f32x4){0.f, 0.f, 0.f, 0.f};
            acc = __builtin_amdgcn_mfma_f32_16x16x32_bf16(ldfrag(sU, tt * 16, 0, LU, fr, fq), ldfrag(sBb, jt * 16, 0, LU, fr, fq), acc, 0, 0, 0);
#pragma unroll
            for (int r = 0; r < 4; ++r) sBU[(tt * 16 + fq * 4 + r) * 128 + jt * 16 + fr] = acc[r]; }
        __syncthreads();
        if (cidx + 1 < 68 && tid_ < 256) { int len2, rowbase2, c02; chunk_pos(cidx + 1, b, len2, rowbase2, c02); const int i = tid_ >> 2, hq = tid_ & 3, pi = c02 + i, t = d ? (len2 - 1 - pi) : pi;
            uraw = *(const u32x2*)(proj + (size_t)(rowbase2 + t) * NE_MAIN + g * 16 + hq * 4); }
        if (tid_ < 128) {
            float bun = sBU[tid_];
            for (int i = 0; i < 64; ++i) {
                const float bu = bun; if (i < 63) bun = sBU[(i + 1) * 128 + tid_];
                const float xp = dppmov<0xB1>(x);
                x = lbr * x + lis * xp + bu;
                sX[i * LQ + tid_] = f2bf(x);
            }
        }
        __syncthreads();
        if (wid < 4) {
            f32x4 acc = (f32x4){0.f, 0.f, 0.f, 0.f};
#pragma unroll
            for (int ks = 0; ks < 4; ++ks) acc = __builtin_amdgcn_mfma_f32_16x16x32_bf16(ldfrag(sX, wid * 16, ks, LQ, fr, fq), ldfrag(sCm, 0, ks, LQ, fr, fq), acc, 0, 0, 0);
#pragma unroll
            for (int r = 0; r < 4; ++r) { const int pi = c0 + wid * 16 + fq * 4 + r, t = d ? (len - 1 - pi) : pi;
                yd[(size_t)(rowbase + t) * DM + g * 16 + fr] = f2bf(acc[r]); }
        }
    }
}

__device__ void scan_s5v3(CP& p, unsigned char* shm, int id2) {
    OPQ_IDS;
    const int lane = tid_ & 63, wid = tid_ >> 6, fr = lane & 15, fq = lane >> 4;
    const int sl = wid >> 1, wp = wid & 1, j = tid_ & 127, st = j >> 1, part = j & 1;
    const int s = id2 * 4 + sl, b = s >> 6, rem = s & 63, g = rem >> 1, d = rem & 1, dg = d * 32 + g;
    constexpr int LU = 40, SCAN_BYTES = 2560 + 8704 + 16384;
    unsigned char* sb = shm + sl * SCAN_BYTES;
    bf16_t* sU = (bf16_t*)sb;
    bf16_t* sX = (bf16_t*)(sb + 2560);
    float* sBU = (float*)(sb + 2560 + 8704);
    const bf16_t* proj = (const bf16_t*)(p.ws + WS_BIG);
    bf16_t* yd = (bf16_t*)(p.ws + WS_BIG + BIG_PROJ) + (size_t)d * MTOT * DM;
    float lbr, lis;
    bf16x8 bfrag[4], cfrag[4];
    {
        bf16_t* tBb = (bf16_t*)shm + sl * (128 * LU);
        bf16_t* tCm = (bf16_t*)shm + 4 * (128 * LU) + sl * (16 * LQ);
        const float lr = p.in[14][dg * 64 + st], li = p.in[15][dg * 64 + st], step = expf(p.in[16][dg]);
        const float ea = lr * step, eb = li * step, mag = expf(ea), cb = cosf(eb), sbn = sinf(eb), shb = sinf(0.5f * eb);
        lbr = mag * cb; const float lbi = mag * sbn;
        const float nr = expm1f(ea) * cb - 2.f * shb * shb, ni = lbi;
        const float den = lr * lr + li * li;
        const float qr = (nr * lr + ni * li) / den, qi = (ni * lr - nr * li) / den;
        lis = part ? lbi : -lbi;
#pragma unroll
        for (int hh = 0; hh < 16; ++hh) { const float br = p.in[17][(size_t)(dg * 64 + st) * 16 + hh], bi = p.in[18][(size_t)(dg * 64 + st) * 16 + hh];
            const float v = part ? (qr * bi + qi * br) : (qr * br - qi * bi);
            const bf16_t hi = f2bf(v); const bf16_t lo = f2bf(v - bf2f(hi));
            tBb[j * LU + hh] = hi; tBb[j * LU + 16 + hh] = lo;
            tCm[hh * LQ + j] = f2bf(part ? -p.in[20][(size_t)(dg * 16 + hh) * 64 + st] : p.in[19][(size_t)(dg * 16 + hh) * 64 + st]); }
        __syncthreads();
#pragma unroll
        for (int q = 0; q < 4; ++q) { bfrag[q] = ldfrag(tBb, (wp * 4 + q) * 16, 0, LU, fr, fq); cfrag[q] = ldfrag(tCm, 0, q, LQ, fr, fq); }
        __syncthreads();
    }
    float x = 0.f;
    u32x2 uraw;
    { const int i = j >> 2, hq = j & 3, t = d ? (CTXL - 1 - i) : i;
      uraw = *(const u32x2*)(proj + (size_t)(MLAT + b * CTXL + t) * NE_MAIN + g * 16 + hq * 4); }
    for (int cidx = 0; cidx < 136; ++cidx) {
        int len, rowbase, c0;
        if (cidx < 8) { len = CTXL; rowbase = MLAT + b * CTXL; c0 = cidx * 32; } else { len = SEQ; rowbase = b * SEQ; c0 = (cidx - 8) * 32; }
        { const int i = j >> 2, hq = j & 3; *(u32x2*)(sU + i * LU + hq * 4) = uraw; *(u32x2*)(sU + i * LU + 16 + hq * 4) = uraw; }
        __syncthreads();
#pragma unroll
        for (int tt = 0; tt < 2; ++tt) { const bf16x8 au = ldfrag(sU, tt * 16, 0, LU, fr, fq);
#pragma unroll
            for (int q = 0; q < 4; ++q) { f32x4 acc = (f32x4){0.f, 0.f, 0.f, 0.f};
                acc = __builtin_amdgcn_mfma_f32_16x16x32_bf16(au, bfrag[q], acc, 0, 0, 0);
#pragma unroll
                for (int r = 0; r < 4; ++r) sBU[(tt * 16 + fq * 4 + r) * 128 + (wp * 4 + q) * 16 + fr] = acc[r]; } }
        __syncthreads();
        if (cidx + 1 < 136) { const int cn = cidx + 1; int len2, rowbase2, c02;
            if (cn < 8) { len2 = CTXL; rowbase2 = MLAT + b * CTXL; c02 = cn * 32; } else { len2 = SEQ; rowbase2 = b * SEQ; c02 = (cn - 8) * 32; }
            const int i = j >> 2, hq = j & 3, pi = c02 + i, t = d ? (len2 - 1 - pi) : pi;
            uraw = *(const u32x2*)(proj + (size_t)(rowbase2 + t) * NE_MAIN + g * 16 + hq * 4); }
        {
            float bun = sBU[j];
            for (int i = 0; i < 32; ++i) {
                const float bu = bun; if (i < 31) bun = sBU[(i + 1) * 128 + j];
                const float xp = dppmov<0xB1>(x);
                x = lbr * x + lis * xp + bu;
                sX[i * LQ + j] = f2bf(x);
            }
        }
        __syncthreads();
        {
            f32x4 acc = (f32x4){0.f, 0.f, 0.f, 0.f};
#pragma unroll
            for (int ks = 0; ks < 4; ++ks) acc = __builtin_amdgcn_mfma_f32_16x16x32_bf16(ldfrag(sX, wp * 16, ks, LQ, fr, fq), cfrag[ks], acc, 0, 0, 0);
#pragma unroll
            for (int r = 0; r < 4; ++r) { const int pi = c0 + wp * 16 + fq * 4 + r, t = d ? (len - 1 - pi) : pi;
                yd[(size_t)(rowbase + t) * DM + g * 16 + fr] = f2bf(acc[r]); }
        }
    }
}

__device__ void phase_post_even(CP& p) {
    OPQ_IDS;
    const int lane = tid_ & 63, wid = tid_ >> 6;
    const bf16_t* proj = (const bf16_t*)(p.ws + WS_BIG);
    const bf16_t* yd0 = (const bf16_t*)(p.ws + WS_BIG + BIG_PROJ); const bf16_t* yd1 = yd0 + (size_t)MTOT * DM;
    bf16_t* ybuf = (bf16_t*)(p.ws + WS_YBUF); bf16_t* ys5 = (bf16_t*)(p.ws + WS_YS5);
    for (int row = bid_ * 8 + wid; row < MTOT; row += gridDim.x * 8) {
        int t, len;
        if (row < MLAT) { t = row & (SEQ - 1); len = SEQ; } else { t = (row - MLAT) & (CTXL - 1); len = CTXL; }
        const bf16_t* pr = proj + (size_t)row * NE_MAIN;
        {
            const int c = lane * 8; float u[8], a[8], bq[8], dd[8], o[8];
            ld8(pr + c, u); ld8(yd0 + (size_t)row * DM + c, a); ld8(yd1 + (size_t)row * DM + c, bq); ldf8(p.in[21] + c, dd);
#pragma unroll
            for (int q = 0; q < 8; ++q) o[q] = gelu_tanh(dd[q] * u[q] + a[q] + bq[q]);
            st8(ys5 + (size_t)row * 512 + c, o);
        }
        for (int grp = 0; grp < 4; ++grp) {
            const bool act = lane < 48; const int ch = grp * 384 + (act ? lane : 0) * 8;
            float o[8]; float ss = 0.f;
            if (act) {
                float xm[8], x0[8], xp[8], a[8], bq[8], z[8], w0[8], w1[8], w2[8], cbv[8];
                ld8(pr + 2048 + ch, x0);
                if (t > 0) ld8(pr - NE_MAIN + 2048 + ch, xm); else { for (int q = 0; q < 8; ++q) xm[q] = 0.f; }
                if (t < len - 1) ld8(pr + NE_MAIN + 2048 + ch, xp); else { for (int q = 0; q < 8; ++q) xp[q] = 0.f; }
                ldf8(p.in[23] + ch, w0); ldf8(p.in[23] + 2560 + ch, w1); ldf8(p.in[23] + 5120 + ch, w2); ldf8(p.in[24] + ch, cbv);
                ld8(yd0 + (size_t)row * DM + 512 + ch, a); ld8(yd1 + (size_t)row * DM + 512 + ch, bq); ld8(pr + 512 + ch, z);
                const float dsk = p.in[27][ch >> 6];
#pragma unroll
                for (int q = 0; q < 8; ++q) { const float xs = siluf_(cbv[q] + w0[q] * xm[q] + w1[q] * x0[q] + w2[q] * xp[q]);
                    const float y = (a[q] + bq[q] + dsk * xs) * siluf_(z[q]); o[q] = y; ss += y * y; }
            }
            ss = red64(ss);
            const float rs = rsqrtf(ss * (1.f / 384.f) + 1e-6f);
            if (act) { float nwv[8]; ldf8(p.in[28] + ch, nwv);
#pragma unroll
                for (int q = 0; q < 8; ++q) o[q] = o[q] * rs * nwv[q];
                st8(ybuf + (size_t)row * DM + 512 + ch, o); }
        }
    }
}

__device__ void phase_post_odd(CP& p) {
    OPQ_IDS;
    const int lane = tid_ & 63, wid = tid_ >> 6;
    const bf16_t* proj = (const bf16_t*)(p.ws + WS_BIG);
    const bf16_t* yd0 = (const bf16_t*)(p.ws + WS_BIG + BIG_PROJ); const bf16_t* yd1 = yd0 + (size_t)MTOT * DM;
    const float* den0 = (const float*)(p.ws + WS_DEN); const float* den1 = den0 + (size_t)MTOT * 4;
    bf16_t* ybuf = (bf16_t*)(p.ws + WS_YBUF);
    for (int row = bid_ * 8 + wid; row < MTOT; row += gridDim.x * 8) {
        const bf16_t* pr = proj + (size_t)row * NO_MAIN;
        for (int half = 0; half < 2; ++half) {
            const int c = half * 512 + lane * 8; float a[8], bq[8], z[8], nwv[8], o[8]; float ss = 0.f;
            ld8(yd0 + (size_t)row * DM + c, a); ld8(yd1 + (size_t)row * DM + c, bq); ld8(pr + 3072 + c, z); ldf8(p.in[34] + (c & 127), nwv);
#pragma unroll
            for (int q = 0; q < 8; ++q) { o[q] = a[q] + bq[q]; ss += o[q] * o[q]; }
            ss = red16(ss);
            const float rs = rsqrtf(ss * (1.f / 128.f) + 1e-6f);
#pragma unroll
            for (int q = 0; q < 8; ++q) o[q] = o[q] * rs * nwv[q] * siluf_(z[q]);
            st8(ybuf + (size_t)row * DM + c, o);
        }
        for (int half = 0; half < 2; ++half) {
            const int c = half * 512 + lane * 8, hd = c >> 8; float a[8], bq[8], om[8], nwv[8], o[8]; float ss = 0.f;
            ld8(yd0 + (size_t)row * DM + 1024 + c, a); ld8(yd1 + (size_t)row * DM + 1024 + c, bq); ld8(pr + 6144 + c, om); ldf8(p.in[37] + c, nwv);
            const float i0 = 1.f / fmaxf(fabsf(den0[(size_t)row * 4 + hd]), 1.f), i1 = 1.f / fmaxf(fabsf(den1[(size_t)row * 4 + hd]), 1.f);
#pragma unroll
            for (int q = 0; q < 8; ++q) { o[q] = a[q] * i0 + bq[q] * i1; ss += o[q] * o[q]; }
            ss = red32(ss);
            const float rs = rsqrtf(ss * (1.f / 256.f) + 1e-6f);
#pragma unroll
            for (int q = 0; q < 8; ++q) o[q] = o[q] * rs * nwv[q] * sigmoidf_(om[q]);
            st8(ybuf + (size_t)row * DM + 1024 + c, o);
        }
    }
}

#define XB_TMO      128
#define XB_XCNT(j)  (256  + 64 * (j))
#define XB_XSUB(j)  (1280 + 64 * (j))
#define XB_XGEN(j)  (2304 + 64 * (j))
#define XB_TOP      3328
#define XB_TOPGEN   3392
#define XCD_BAR_WORDS 3456
#define XB_SPIN_CAP (1u << 18)
__device__ __forceinline__ unsigned xb_ld(unsigned* p)              { return __hip_atomic_load(p, __ATOMIC_RELAXED, __HIP_MEMORY_SCOPE_AGENT); }
__device__ __forceinline__ unsigned xb_add(unsigned* p, unsigned v) { return __hip_atomic_fetch_add(p, v, __ATOMIC_RELAXED, __HIP_MEMORY_SCOPE_AGENT); }
__device__ __forceinline__ unsigned xb_xcc_id() { return (unsigned)__builtin_amdgcn_s_getreg((3 << 11) | 20) & 0xFu; }
#define XB_SPIN(cond, bar) do { unsigned _sp = 0; while (cond) { __builtin_amdgcn_s_sleep(1); \
    if ((++_sp & 255u) == 0u) { if (xb_ld(&(bar)[XB_TMO])) break; if (_sp > XB_SPIN_CAP) { atomicAdd(&(bar)[XB_TMO], 1u); break; } } } } while (0)
struct XcdBarrier { unsigned* bar; unsigned x; volatile LAS unsigned* st; };
__device__ __forceinline__ void xcd_barrier_complete(unsigned* bar, unsigned x, unsigned& nloc, unsigned& nx) {
    const unsigned G = gridDim.x * gridDim.y * gridDim.z;
    unsigned sum, cnt, mine, sp = 0u;
    for (;;) {
        sum = 0u; cnt = 0u; mine = 0u;
#pragma unroll
        for (unsigned j = 0; j < 16; ++j) { const unsigned c = xb_ld(&bar[XB_XCNT(j)]); sum += c; cnt += (c > 0u) ? 1u : 0u; mine = (j == x) ? c : mine; }
        if (sum == G) break;
        __builtin_amdgcn_s_sleep(1);
        if ((++sp & 255u) == 0u) { if (xb_ld(&bar[XB_TMO])) break; if (sp > XB_SPIN_CAP) { atomicAdd(&bar[XB_TMO], 1u); break; } }
    }
    nloc = mine > 0u ? mine : 1u; nx = cnt > 0u ? cnt : 1u;
}
__device__ __forceinline__ void xcd_barrier(const XcdBarrier& b) {
    asm volatile("s_waitcnt vmcnt(0)" ::: "memory");
    __syncthreads();
    if (threadIdx.x == 0) {
        unsigned* bar = b.bar;
        __builtin_amdgcn_s_waitcnt(0);
        unsigned nloc = b.st[0], nx = b.st[1];
        if (nloc == 0u) { xcd_barrier_complete(bar, b.x, nloc, nx); b.st[0] = nloc; b.st[1] = nx; }
        const unsigned old = xb_add(&bar[XB_XSUB(b.x)], 1u);
        const unsigned gen = old / nloc;
        if (old + 1u == (gen + 1u) * nloc) {
            __builtin_amdgcn_fence(__ATOMIC_RELEASE, "agent");
            asm volatile("s_waitcnt vmcnt(0)" ::: "memory");
            const unsigned og = xb_add(&bar[XB_TOP], 1u);
            const unsigned tg = og / nx;
            if (og + 1u == (tg + 1u) * nx) xb_add(&bar[XB_TOPGEN], 1u);
            else XB_SPIN(xb_ld(&bar[XB_TOPGEN]) == tg, bar);
            __builtin_amdgcn_fence(__ATOMIC_ACQUIRE, "agent");
            xb_add(&bar[XB_XGEN(b.x)], 1u);
            asm volatile("s_waitcnt vmcnt(0)" ::: "memory");
        } else {
            XB_SPIN(xb_ld(&bar[XB_XGEN(b.x)]) == gen, bar);
            __builtin_amdgcn_fence(__ATOMIC_ACQUIRE, "agent");
            asm volatile("s_waitcnt vmcnt(0)" ::: "memory");
        }
    }
    __syncthreads();
}

__global__ void __launch_bounds__(NTHR, 2) fwd_megakernel(Params p_unused) {
    extern __shared__ __attribute__((aligned(16))) unsigned char shm[];
    cg::grid_group grid = cg::this_grid();
    volatile LAS unsigned* xb_st = (volatile LAS unsigned*)((LAS unsigned char*)shm + (LDS_BYTES - 16));
    if (threadIdx.x == 0) { xb_st[0] = 0u; xb_st[1] = 0u; }
    {
        CP* kp0 = (CP*)__builtin_amdgcn_kernarg_segment_ptr();
        unsigned* bw = (unsigned*)(kp0->ws + WS_BARW);
        if (blockIdx.x == 0) for (int e = threadIdx.x; e < XCD_BAR_WORDS; e += NTHR) bw[e] = 0u;
    }
    __syncthreads();
    for (int ph = 0; ph < 23; ++ph) {
        CP* kp = (CP*)__builtin_amdgcn_kernarg_segment_ptr(); asm volatile("" : "+s"(kp));
        CP& p = *kp;
        int bidk = blockIdx.x; asm volatile("" : "+s"(bidk));
        unsigned char* ws = p.ws;
        float* xc = (float*)(ws + WS_XC);
        bf16_t* act = (bf16_t*)(ws + WS_ACT);
        bf16_t* ybuf = (bf16_t*)(ws + WS_YBUF);
        bf16_t* big = (bf16_t*)(ws + WS_BIG);
        float* gates = (float*)(ws + WS_GATES);
        const float* modf = (const float*)(ws + WS_MODF);
        if (ph == 0) phase_prologue(p, shm);
        else if (ph == 1) phase_modreduce(p);
        else if (ph == 22) phase_final_norm(p);
        else {
            const int layer = (ph - 2) / 10, sub = (ph - 2) % 10;
            const bool even = (layer == 0);
            const int mres = even ? MTOT : MLAT;
            if (sub == 4 && !even) continue;
            if (sub == 0) phase_norm(p, layer, 0, MTOT, even);
            else if (sub == 6) phase_norm(p, layer, 1, mres, false);
            else if (sub == 1 || sub == 7) {
                const bool up = (sub == 7);
                const int nmain = up ? UPN : (even ? NE_MAIN : NO_MAIN), N = up ? UPN : (even ? NE : NO);
                const size_t wo = up ? (even ? WS_WUP0 : WS_WUP1) : (even ? WS_WINE : WS_WINO);
                pg8::EpiOut E{big, nmain, nmain / 256, gates};
                run_gemm(shm, act, DM, (const bf16_t*)(ws + wo), up ? mres : MTOT, N, DM, E);
            }
            else if (sub == 2) {
                if (even) { ssd_bc_prepass(p);
                            { XcdBarrier xb2; xb2.bar = (unsigned*)(ws + WS_BARW); xb2.x = xb_xcc_id(); xb2.st = xb_st; xcd_barrier(xb2); }
                            if (bidk < 192) scan_la<4, true, 64>(p, shm, bidk); else if (bidk < 256) scan_s5v3(p, shm, bidk - 192); }
                else      { gdn_qk_prepass(p);
                            { XcdBarrier xb2; xb2.bar = (unsigned*)(ws + WS_BARW); xb2.x = xb_xcc_id(); xb2.st = xb_st; xcd_barrier(xb2); }
                            if (bidk < 256) scan_gdn256(p, shm, bidk); __syncthreads(); if (bidk < 256) scan_la<3, false, 32>(p, shm, bidk); }
            }
            else if (sub == 3) { if (even) phase_post_even(p); else phase_post_odd(p); }
            else if (sub == 4) { pg8::EpiGlu E{(const bf16_t*)(ws + WS_YS5), ybuf}; run_gemm(shm, (const bf16_t*)(ws + WS_YS5), 512, (const bf16_t*)(ws + WS_WGLU), MTOT, 512, 512, E); }
            else if (sub == 5 || sub == 9) {
                const bool dn = (sub == 9);
                const bool first = even && !dn;
                pg8::EpiResid E{first ? p.in[0] : p.out, first ? p.in[2] : xc, p.out, xc, modf + (size_t)layer * 5 * MODN + (dn ? 5 : 2) * DM};
                const size_t wo = dn ? (even ? WS_WDN0 : WS_WDN1) : (even ? WS_WOUT0 : WS_WOUT1);
                run_gemm(shm, dn ? big + FFN : ybuf, dn ? UPN : DM, (const bf16_t*)(ws + wo), mres, DM, dn ? FFN : DM, E);
            }
            else if (sub == 8) phase_ffnconv(p, layer, mres);
        }
        if (ph == 0) { grid.sync(); if (threadIdx.x == 0) (void)xb_add(&((unsigned*)(ws + WS_BARW))[XB_XCNT(xb_xcc_id())], 1u); }
        else if (ph < 22) { XcdBarrier xb; xb.bar = (unsigned*)(ws + WS_BARW); xb.x = xb_xcc_id(); xb.st = xb_st; xcd_barrier(xb); }
    }
}

extern "C" void kernel_launch(void* const* d_in, const int* in_sizes, int n_in, void* d_out, int out_size, void* d_ws, size_t ws_size, hipStream_t stream) {
    static int grid_blocks = 0;
    if (grid_blocks == 0) {
        if (n_in != 38 || out_size != MLAT * DM || ws_size < WS_END) { fprintf(stderr, "kernel_launch: unexpected shapes: n_in %d out %d ws %zu (need %zu)\n", n_in, out_size, ws_size, (size_t)WS_END); grid_blocks = -1; return; }
        int dev = 0, cus = 0, per_cu = 0;
        hipGetDevice(&dev);
        hipDeviceGetAttribute(&cus, hipDeviceAttributeMultiprocessorCount, dev);
        if (hipFuncSetAttribute((const void*)fwd_megakernel, hipFuncAttributeMaxDynamicSharedMemorySize, LDS_BYTES) != hipSuccess) { fprintf(stderr, "kernel_launch: hipFuncSetAttribute failed\n"); grid_blocks = -1; return; }
        hipOccupancyMaxActiveBlocksPerMultiprocessor(&per_cu, (const void*)fwd_megakernel, NTHR, LDS_BYTES);
        if (per_cu < 1) { fprintf(stderr, "kernel_launch: occupancy query says %d blocks/CU\n", per_cu); per_cu = 1; }
        (void)hipGetLastError();
        grid_blocks = cus;
        if (grid_blocks < 256) fprintf(stderr, "kernel_launch: only %d CUs; scans need 256 workgroups\n", grid_blocks);
        if (grid_blocks > 256) grid_blocks = 256;
    }
    if (grid_blocks < 0) return;
    Params p{};
    for (int i = 0; i < 38; ++i) p.in[i] = (const float*)d_in[i];
    p.out = (float*)d_out; p.ws = (unsigned char*)d_ws;
    void* args[] = {&p};
    hipError_t e = hipLaunchCooperativeKernel((const void*)fwd_megakernel, dim3(grid_blocks), dim3(NTHR), args, LDS_BYTES, stream);
    if (e != hipSuccess) fprintf(stderr, "cooperative launch failed: %s (grid %d)\n", hipGetErrorString(e), grid_blocks);
}
```

```cpp
#include <hip/hip_runtime.h>
#include <hip/hip_cooperative_groups.h>
#include <cstdio>
namespace cg = cooperative_groups;

#define LAS __attribute__((address_space(3)))
typedef unsigned short bf16_t;
typedef short bf16x8 __attribute__((ext_vector_type(8)));
typedef float f32x4 __attribute__((ext_vector_type(4)));
typedef unsigned u32x4 __attribute__((ext_vector_type(4)));
typedef unsigned u32x2 __attribute__((ext_vector_type(2)));
typedef float f32x2 __attribute__((ext_vector_type(2)));

constexpr int DM = 2048, NBATCH = 4, SEQ = 4096, CTXL = 256;
constexpr int MLAT = NBATCH * SEQ, MCTX = NBATCH * CTXL, MTOT = MLAT + MCTX;
constexpr int NE_MAIN = 4608, NE = 4864, NE_SRC = 4656;
constexpr int NO_MAIN = 7168, NO = 7424, NO_SRC = 7216;
constexpr int FFN = 5504, UPN = 11008;
constexpr int MODN = 6 * DM;
constexpr int NTHR = 512;
constexpr int LDS_BYTES = 136 * 1024;

constexpr size_t al256(size_t x) { return (x + 255) & ~size_t(255); }
constexpr size_t WS_WINE = 0;
constexpr size_t WS_WINO = WS_WINE + al256((size_t)NE * DM * 2);
constexpr size_t WS_WOUT0 = WS_WINO + al256((size_t)NO * DM * 2);
constexpr size_t WS_WOUT1 = WS_WOUT0 + al256((size_t)DM * DM * 2);
constexpr size_t WS_WUP0 = WS_WOUT1 + al256((size_t)DM * DM * 2);
constexpr size_t WS_WUP1 = WS_WUP0 + al256((size_t)UPN * DM * 2);
constexpr size_t WS_WDN0 = WS_WUP1 + al256((size_t)UPN * DM * 2);
constexpr size_t WS_WDN1 = WS_WDN0 + al256((size_t)DM * FFN * 2);
constexpr size_t WS_WGLU = WS_WDN1 + al256((size_t)DM * FFN * 2);
constexpr size_t WS_MODP = WS_WGLU + al256((size_t)512 * 512 * 2);
constexpr size_t WS_MODF = WS_MODP + al256((size_t)32 * 2 * 5 * MODN * 4);
constexpr size_t WS_XC = WS_MODF + al256((size_t)2 * 5 * MODN * 4);
constexpr size_t WS_ACT = WS_XC + al256((size_t)MCTX * DM * 4);
constexpr size_t WS_YBUF = WS_ACT + al256((size_t)MTOT * DM * 2);
constexpr size_t WS_GATES = WS_YBUF + al256((size_t)MTOT * DM * 2);
constexpr size_t WS_DEN = WS_GATES + al256((size_t)MTOT * 64 * 4);
constexpr size_t WS_YS5 = WS_DEN + al256((size_t)2 * MTOT * 4 * 4);
constexpr size_t WS_BIG = WS_YS5 + al256((size_t)MTOT * 512 * 2);
constexpr size_t BIG_PROJ = al256((size_t)MTOT * NO_MAIN * 2);
constexpr size_t BIG_A = BIG_PROJ + al256((size_t)2 * MTOT * DM * 2);
constexpr size_t BIG_B = al256((size_t)MTOT * UPN * 2);
constexpr size_t WS_BARW = WS_BIG + (BIG_A > BIG_B ? BIG_A : BIG_B);
constexpr size_t WS_END = WS_BARW + 16384;

struct Params { const float* in[38]; float* out; unsigned char* ws; };
typedef const __attribute__((address_space(4))) Params CP;
#define OPQ_IDS int tid_ = threadIdx.x; asm volatile("" : "+v"(tid_)); int bid_ = blockIdx.x; asm volatile("" : "+s"(bid_))

__device__ __forceinline__ float bf2f(bf16_t b) { return __uint_as_float(((unsigned)b) << 16); }
typedef __bf16 bf16x2_t __attribute__((ext_vector_type(2)));
__device__ __forceinline__ bf16_t f2bf(float f) { const __bf16 h = (__bf16)f; return __builtin_bit_cast(unsigned short, h); }
__device__ __forceinline__ unsigned pack2(float lo, float hi) { bf16x2_t v; v[0] = (__bf16)lo; v[1] = (__bf16)hi; return __builtin_bit_cast(unsigned, v); }
__device__ __forceinline__ float lo16(unsigned w) { return __uint_as_float(w << 16); }
__device__ __forceinline__ float hi16(unsigned w) { return __uint_as_float(w & 0xFFFF0000u); }
__device__ __forceinline__ float sigmoidf_(float x) { return __builtin_amdgcn_rcpf(1.f + __expf(-x)); }
__device__ __forceinline__ float siluf_(float x) { return x * __builtin_amdgcn_rcpf(1.f + __expf(-x)); }
__device__ __forceinline__ float softplusf_(float x) { return fmaxf(x, 0.f) + log1pf(expf(-fabsf(x))); }
__device__ __forceinline__ float gelu_tanh(float x) { const float u = 0.7978845608028654f * (x + 0.044715f * x * x * x); return 0.5f * x * (1.f + tanhf(u)); }
template <int CTRL> __device__ __forceinline__ float dppmov(float v) { return __int_as_float(__builtin_amdgcn_update_dpp(0, __float_as_int(v), CTRL, 0xF, 0xF, true)); }
__device__ __forceinline__ float red8(float v) { v += dppmov<0xB1>(v); v += dppmov<0x4E>(v); v += dppmov<0x141>(v); return v; }
__device__ __forceinline__ float red16(float v) { v = red8(v); v += dppmov<0x140>(v); return v; }
__device__ __forceinline__ float red32(float v) { v = red16(v); v += __shfl_xor(v, 16, 64); return v; }
__device__ __forceinline__ float red64(float v) { v = red16(v); v += __shfl_xor(v, 16, 64); v += __shfl_xor(v, 32, 64); return v; }

namespace pg8 {
constexpr int BM = 256, BK = 64, HALF = 128, HTB = HALF * BK * 2, STAGE_BYTES = 8 * HTB, NXCD = 8, WGM = 8;
__device__ __forceinline__ int lds_byte(int r, int c) { const int st = (r >> 4) * 2 + (c >> 5), rr = r & 15, cc = c & 31, ob = rr * 64 + cc * 2; return st * 1024 + (ob ^ (((ob >> 9) & 1) << 5)); }
__device__ __forceinline__ void stage_rc(int b, int& R, int& C) { const int st = b / 1024, sb = b % 1024, swz = sb ^ (((sb >> 9) & 1) << 5); R = (st >> 1) * 16 + swz / 64; C = (st & 1) * 32 + (swz % 64) / 2; }
__device__ __forceinline__ int perm32(int rho) { const int n = rho >> 4, i = rho & 15; return 8 * (i >> 2) + 4 * n + (i & 3); }
struct Unit { int pm, pn; };
struct Gemm { const bf16_t* A; const bf16_t* Bt; int M, N, K, lda; };
struct StaticOrder {
    int nM, nN, nwg, G, c;
    __device__ void init(int M, int N, int G_, int c_) { nM = M / BM; nN = N / BM; nwg = nM * nN; G = G_; c = c_; }
    __device__ bool next(int i, Unit& u) const {
        const long L = (long)i * G + c; if (L >= nwg) return false;
        int wgid = (int)L; { const int q = nwg / NXCD, r = nwg % NXCD, xcd = wgid % NXCD, off = wgid / NXCD; wgid = (xcd < r ? xcd * (q + 1) : r * (q + 1) + (xcd - r) * q) + off; }
        const int nig = WGM * nN, gid = wgid / nig, fm = gid * WGM, gsz = (nM - fm) < WGM ? (nM - fm) : WGM;
        u.pm = fm + ((wgid % nig) % gsz); u.pn = (wgid % nig) / gsz; return true;
    }
};
__device__ __forceinline__ unsigned cvt_pk_bf16(float lo, float hi) { unsigned r; asm volatile("v_cvt_pk_bf16_f32 %0, %1, %2" : "=v"(r) : "v"(lo), "v"(hi)); return r; }

template <class Epi>
__device__ __forceinline__ void gemm_phase(LAS unsigned char* lds, const Gemm g, const StaticOrder& S, const Epi& E) {
    int tid = threadIdx.x; asm volatile("" : "+v"(tid));
    const int wid = __builtin_amdgcn_readfirstlane(tid >> 6), lane = tid & 63, wr = wid >> 2, wc = wid & 3, fr = lane & 15, fq = lane >> 4;
    const int K = g.K, nt = K / BK, lda = g.lda;
    unsigned voffA[2], voffB[2];
#pragma unroll
    for (int i = 0; i < 2; ++i) { int R, C; stage_rc(tid * 16 + i * 8192, R, C); const int Rb = Epi::PERM ? ((R & ~31) + perm32(R & 31)) : R;
        voffA[i] = (unsigned)(R * lda + C) * 2u; voffB[i] = (unsigned)(Rb * K + C) * 2u; }
    const size_t kstep = (size_t)(BK * 2);
    const size_t hstepA = (size_t)HALF * lda * 2, hstepB = (size_t)HALF * K * 2;
    const size_t tstepA = 2 * hstepA, tstepB = 2 * hstepB;
    const unsigned ldsw = (unsigned)wid * 1024u;
    const int aoff = lds_byte(wr * 64 + fr, fq * 8), boff = lds_byte(wc * 32 + fr, fq * 8);
#define PG8_SA(b, h) (((b) * 2 + (h)) * HTB)
#define PG8_SB(b, h) ((4 + (b) * 2 + (h)) * HTB)
#define PG8_STAGE(bufoff, gbase, voff) do { _Pragma("unroll") for (int _i = 0; _i < 2; ++_i) \
        __builtin_amdgcn_global_load_lds((const unsigned*)((const char*)(gbase) + (voff)[_i]), (LAS unsigned*)(lds + (bufoff) + ldsw + _i * 8192), 16, 0, 0); } while (0)
#define PG8_LDA(dst, b, h) do { _Pragma("unroll") for (int m = 0; m < 4; ++m) _Pragma("unroll") for (int k = 0; k < 2; ++k) dst[m][k] = *(const LAS bf16x8*)(lds + PG8_SA(b, h) + aoff + m * 2048 + k * 1024); } while (0)
#define PG8_LDB(dst, b, h) do { _Pragma("unroll") for (int n = 0; n < 2; ++n) _Pragma("unroll") for (int k = 0; k < 2; ++k) dst[n][k] = *(const LAS bf16x8*)(lds + PG8_SB(b, h) + boff + n * 2048 + k * 1024); } while (0)
#define PG8_MMA(ai, bj, At, Bt) do { __builtin_amdgcn_s_setprio(1); _Pragma("unroll") for (int m = 0; m < 4; ++m) _Pragma("unroll") for (int n = 0; n < 2; ++n) _Pragma("unroll") for (int k = 0; k < 2; ++k) \
        acc[ai][bj][m][n] = __builtin_amdgcn_mfma_f32_16x16x32_bf16(Bt[n][k], At[m][k], acc[ai][bj][m][n], 0, 0, 0); __builtin_amdgcn_s_setprio(0); } while (0)
#define PG8_WAIT_V(n) asm volatile("s_waitcnt vmcnt(" #n ")" ::: "memory")
#define PG8_WAIT_L(n) asm volatile("s_waitcnt lgkmcnt(" #n ")" ::: "memory")
#define PG8_BAR __builtin_amdgcn_s_barrier()
#define PG8_SCHED __builtin_amdgcn_sched_barrier(0)
    Unit cur, nxt; int ui = 0;
    if (!S.next(0, cur)) return;
    f32x4 acc[2][2][4][2];
#pragma unroll
    for (int a = 0; a < 2; ++a)
#pragma unroll
        for (int b = 0; b < 2; ++b)
#pragma unroll
            for (int m = 0; m < 4; ++m)
#pragma unroll
                for (int n = 0; n < 2; ++n) acc[a][b][m][n] = (f32x4){0.f, 0.f, 0.f, 0.f};
    bf16x8 At[4][2], B0[2][2], B1[2][2];
    const char* cA = (const char*)g.A + (size_t)cur.pm * tstepA; const char* cB = (const char*)g.Bt + (size_t)cur.pn * tstepB;
    PG8_STAGE(PG8_SB(0, 0), cB, voffB); PG8_STAGE(PG8_SA(0, 0), cA, voffA); PG8_STAGE(PG8_SB(0, 1), cB + hstepB, voffB); PG8_STAGE(PG8_SA(0, 1), cA + hstepA, voffA);
    if (wr == 1) PG8_BAR;
    PG8_WAIT_V(4); PG8_BAR;
    PG8_STAGE(PG8_SB(1, 0), cB + kstep, voffB); PG8_STAGE(PG8_SA(1, 0), cA + kstep, voffA); PG8_STAGE(PG8_SB(1, 1), cB + hstepB + kstep, voffB);
    PG8_WAIT_V(6); PG8_BAR;
    for (;;) {
        const bool has_next = S.next(ui + 1, nxt);
        const char* nA = has_next ? (const char*)g.A + (size_t)nxt.pm * tstepA : cA; const char* nB = has_next ? (const char*)g.Bt + (size_t)nxt.pn * tstepB : cB;
        for (int t = 0; t < nt; t += 2) {
            const bool last = (t == nt - 2);
            const char* a1 = cA + (size_t)(t + 1) * kstep;
            const char* a2 = last ? nA : cA + (size_t)(t + 2) * kstep; const char* b2 = last ? nB : cB + (size_t)(t + 2) * kstep;
            const char* a3 = a2 + kstep; const char* b3 = b2 + kstep;
            PG8_LDB(B0, 0, 0); PG8_SCHED; PG8_LDA(At, 0, 0); PG8_STAGE(PG8_SA(1, 1), a1 + hstepA, voffA);
            PG8_WAIT_L(8); PG8_BAR; PG8_WAIT_L(0); PG8_MMA(0, 0, At, B0); PG8_BAR; PG8_SCHED;
            PG8_LDB(B1, 0, 1); PG8_STAGE(PG8_SB(0, 0), b2, voffB);
            PG8_BAR; PG8_WAIT_L(0); PG8_MMA(0, 1, At, B1); PG8_BAR;
            PG8_LDA(At, 0, 1); PG8_STAGE(PG8_SA(0, 0), a2, voffA);
            PG8_BAR; PG8_WAIT_L(0); PG8_MMA(1, 0, At, B0); PG8_BAR; PG8_SCHED;
            PG8_STAGE(PG8_SB(0, 1), b2 + hstepB, voffB);
            PG8_WAIT_V(6); PG8_BAR; PG8_MMA(1, 1, At, B1); PG8_BAR;
            PG8_LDB(B0, 1, 0); PG8_SCHED; PG8_LDA(At, 1, 0); PG8_STAGE(PG8_SA(0, 1), a2 + hstepA, voffA);
            PG8_WAIT_L(8); PG8_BAR; PG8_WAIT_L(0); PG8_MMA(0, 0, At, B0); PG8_BAR; PG8_SCHED;
            PG8_LDB(B1, 1, 1); PG8_STAGE(PG8_SB(1, 0), b3, voffB);
            PG8_BAR; PG8_WAIT_L(0); PG8_MMA(0, 1, At, B1); PG8_BAR;
            PG8_LDA(At, 1, 1); PG8_STAGE(PG8_SA(1, 0), a3, voffA);
            PG8_BAR; PG8_WAIT_L(0); PG8_MMA(1, 0, At, B0); PG8_BAR; PG8_SCHED;
            PG8_STAGE(PG8_SB(1, 1), b3 + hstepB, voffB);
            PG8_WAIT_V(6); PG8_BAR; PG8_MMA(1, 1, At, B1); PG8_BAR;
        }
        E(acc, cur, wr, wc, fr, fq);
        if (!has_next) break;
#pragma unroll
        for (int a = 0; a < 2; ++a)
#pragma unroll
            for (int b = 0; b < 2; ++b)
#pragma unroll
                for (int m = 0; m < 4; ++m)
#pragma unroll
                    for (int n = 0; n < 2; ++n) acc[a][b][m][n] = (f32x4){0.f, 0.f, 0.f, 0.f};
        cur = nxt; cA = nA; cB = nB; ++ui;
    }
    PG8_WAIT_V(0);
    if (wr == 0) PG8_BAR;
    PG8_BAR;
#undef PG8_SA
#undef PG8_SB
#undef PG8_STAGE
#undef PG8_LDA
#undef PG8_LDB
#undef PG8_MMA
#undef PG8_WAIT_V
#undef PG8_WAIT_L
#undef PG8_BAR
#undef PG8_SCHED
}

struct EpiOut {
    static constexpr bool PERM = true;
    bf16_t* O; int ldc; int n_main; float* G;
    __device__ __forceinline__ void operator()(const f32x4 (&acc)[2][2][4][2], const Unit& u, int wr, int wc, int fr, int fq) const {
        const int row0 = u.pm * BM + wr * 64 + fr;
        if (u.pn < n_main) {
            const int col0 = u.pn * BM + wc * 32 + 8 * fq;
#pragma unroll
            for (int ai = 0; ai < 2; ++ai)
#pragma unroll
                for (int m = 0; m < 4; ++m) { bf16_t* rowp = O + (size_t)(row0 + ai * HALF + m * 16) * ldc + col0;
#pragma unroll
                    for (int bj = 0; bj < 2; ++bj) { const f32x4 v0 = acc[ai][bj][m][0], v1 = acc[ai][bj][m][1];
                        u32x4 w; w.x = cvt_pk_bf16(v0[0], v0[1]); w.y = cvt_pk_bf16(v0[2], v0[3]); w.z = cvt_pk_bf16(v1[0], v1[1]); w.w = cvt_pk_bf16(v1[2], v1[3]);
                        *(u32x4*)(rowp + bj * HALF) = w; } }
        } else if (wc < 2) {
#pragma unroll
            for (int ai = 0; ai < 2; ++ai)
#pragma unroll
                for (int m = 0; m < 4; ++m) { float* rowp = G + (size_t)(row0 + ai * HALF + m * 16) * 64 + wc * 32 + 8 * fq;
                    *(f32x4*)(rowp) = acc[ai][0][m][0]; *(f32x4*)(rowp + 4) = acc[ai][0][m][1]; }
        }
    }
};
struct EpiResid {
    static constexpr bool PERM = false;
    const float* xin_lat; const float* xin_ctx; float* xout_lat; float* xout_ctx; const float* gate;
    __device__ __forceinline__ void operator()(const f32x4 (&acc)[2][2][4][2], const Unit& u, int wr, int wc, int fr, int fq) const {
        int rowt = u.pm * BM; const float* xi; float* xo; const float* gv;
        if (rowt < MLAT) { xi = xin_lat + (size_t)rowt * DM; xo = xout_lat + (size_t)rowt * DM; gv = gate + (size_t)(rowt >> 12) * MODN; }
        else { rowt -= MLAT; xi = xin_ctx + (size_t)rowt * DM; xo = xout_ctx + (size_t)rowt * DM; gv = gate + (size_t)4 * MODN; }
        const int lrow0 = wr * 64 + fr, col0 = u.pn * BM + wc * 32 + 4 * fq;
        f32x4 gvv[2][2];
#pragma unroll
        for (int bj = 0; bj < 2; ++bj)
#pragma unroll
            for (int n = 0; n < 2; ++n) gvv[bj][n] = *(const f32x4*)(gv + col0 + bj * HALF + n * 16);
#pragma unroll
        for (int ai = 0; ai < 2; ++ai)
#pragma unroll
            for (int m = 0; m < 4; ++m) { const size_t off = (size_t)(lrow0 + ai * HALF + m * 16) * DM + col0;
#pragma unroll
                for (int bj = 0; bj < 2; ++bj)
#pragma unroll
                    for (int n = 0; n < 2; ++n) { const f32x4 xv = *(const f32x4*)(xi + off + bj * HALF + n * 16);
                        *(f32x4*)(xo + off + bj * HALF + n * 16) = xv + gvv[bj][n] * acc[ai][bj][m][n]; } }
    }
};
struct EpiGlu {
    static constexpr bool PERM = true;
    const bf16_t* Y; bf16_t* O;
    __device__ __forceinline__ void operator()(const f32x4 (&acc)[2][2][4][2], const Unit& u, int wr, int wc, int fr, int fq) const {
        const int row0 = u.pm * BM + wr * 64 + fr, col0 = u.pn * BM + wc * 32 + 8 * fq;
#pragma unroll
        for (int ai = 0; ai < 2; ++ai)
#pragma unroll
            for (int m = 0; m < 4; ++m) { const int row = row0 + ai * HALF + m * 16;
#pragma unroll
                for (int bj = 0; bj < 2; ++bj) { const u32x4 yv = *(const u32x4*)(Y + (size_t)row * 512 + col0 + bj * HALF);
                    const f32x4 v0 = acc[ai][bj][m][0], v1 = acc[ai][bj][m][1];
                    u32x4 w;
                    w.x = cvt_pk_bf16(lo16(yv.x) * sigmoidf_(v0[0]), hi16(yv.x) * sigmoidf_(v0[1]));
                    w.y = cvt_pk_bf16(lo16(yv.y) * sigmoidf_(v0[2]), hi16(yv.y) * sigmoidf_(v0[3]));
                    w.z = cvt_pk_bf16(lo16(yv.z) * sigmoidf_(v1[0]), hi16(yv.z) * sigmoidf_(v1[1]));
                    w.w = cvt_pk_bf16(lo16(yv.w) * sigmoidf_(v1[2]), hi16(yv.w) * sigmoidf_(v1[3]));
                    *(u32x4*)(O + (size_t)row * DM + col0 + bj * HALF) = w; } }
    }
};
}

template <class Epi>
__device__ __forceinline__ void run_gemm(unsigned char* shm, const bf16_t* A, int lda, const bf16_t* Bt, int M, int N, int K, const Epi& E) {
    int bid_ = blockIdx.x; asm volatile("" : "+s"(bid_));
    pg8::Gemm g{A, Bt, M, N, K, lda}; pg8::StaticOrder S; S.init(M, N, (int)gridDim.x, bid_);
    pg8::gemm_phase<Epi>((LAS unsigned char*)shm, g, S, E);
}

__device__ __forceinline__ void ld8(const bf16_t* p, float (&v)[8]) { const u32x4 r = *(const u32x4*)p; v[0] = lo16(r.x); v[1] = hi16(r.x); v[2] = lo16(r.y); v[3] = hi16(r.y); v[4] = lo16(r.z); v[5] = hi16(r.z); v[6] = lo16(r.w); v[7] = hi16(r.w); }
__device__ __forceinline__ void st8(bf16_t* p, const float (&v)[8]) { u32x4 w; w.x = pack2(v[0], v[1]); w.y = pack2(v[2], v[3]); w.z = pack2(v[4], v[5]); w.w = pack2(v[6], v[7]); *(u32x4*)p = w; }
__device__ __forceinline__ void ldf8(const float* p, float (&v)[8]) { const f32x4 a = *(const f32x4*)p, b = *(const f32x4*)(p + 4); v[0] = a[0]; v[1] = a[1]; v[2] = a[2]; v[3] = a[3]; v[4] = b[0]; v[5] = b[1]; v[6] = b[2]; v[7] = b[3]; }


struct CvtDesc { const float* src; bf16_t* dst; int K, Nsrc, Ndst, mode; };
__device__ __forceinline__ int cvt_srccol(int mode, int n, int Nsrc) {
    if (mode == 0) return n < Nsrc ? n : -1;
    if (n < 4096) return n;
    if (n < 7168) return n + 32;
    if (n < 7200) return 4096 + (n - 7168);
    if (n < 7216) return n;
    return -1;
}
constexpr int CVT_T0 = 0;
constexpr int CVT_T1 = CVT_T0 + (NE / 256) * (DM / 64);
constexpr int CVT_T2 = CVT_T1 + (NO / 256) * (DM / 64);
constexpr int CVT_T3 = CVT_T2 + (DM / 256) * (DM / 64);
constexpr int CVT_T4 = CVT_T3 + (DM / 256) * (DM / 64);
constexpr int CVT_T5 = CVT_T4 + (UPN / 256) * (DM / 64);
constexpr int CVT_T6 = CVT_T5 + (UPN / 256) * (DM / 64);
constexpr int CVT_T7 = CVT_T6 + (DM / 256) * (FFN / 64);
constexpr int CVT_T8 = CVT_T7 + (DM / 256) * (FFN / 64);
constexpr int CVT_T9 = CVT_T8 + 2 * 8;
constexpr int N_MOD_ITEMS = 2 * 6 * 32;
constexpr int CVT_PITCH = 260;

__device__ void phase_prologue(CP& p, unsigned char* shm) {
    OPQ_IDS;
    const int tid = tid_;
    float* lds = (float*)shm;
    unsigned char* ws = p.ws;
    for (int item = bid_; item < N_MOD_ITEMS + CVT_T9; item += gridDim.x) {
        if (item < N_MOD_ITEMS) {
            const int layer = item / 192, rem = item % 192, cc = rem >> 5, kc = rem & 31;
            if (tid < 320) { const int r = tid >> 6, k = tid & 63; const float v = (r < 4) ? p.in[1][r * DM + kc * 64 + k] : p.in[3][kc * 64 + k]; lds[tid] = v / (1.f + expf(-v)); }
            __syncthreads();
            const int col = cc * 2048 + tid * 4;
            const float* w = p.in[4] + ((size_t)layer * DM + kc * 64) * MODN + col;
            f32x4 a0 = {0.f, 0.f, 0.f, 0.f}, a1 = a0, a2 = a0, a3 = a0, a4 = a0;
#pragma unroll 16
            for (int k = 0; k < 64; ++k) { const f32x4 wv = *(const f32x4*)(w + (size_t)k * MODN); a0 += wv * lds[k]; a1 += wv * lds[64 + k]; a2 += wv * lds[128 + k]; a3 += wv * lds[192 + k]; a4 += wv * lds[256 + k]; }
            float* mp = (float*)(ws + WS_MODP) + ((size_t)(kc * 2 + layer) * 5) * MODN + col;
            *(f32x4*)(mp) = a0; *(f32x4*)(mp + MODN) = a1; *(f32x4*)(mp + 2 * MODN) = a2; *(f32x4*)(mp + 3 * MODN) = a3; *(f32x4*)(mp + 4 * MODN) = a4;
            __syncthreads();
        } else {
            const int t = item - N_MOD_ITEMS;
            CvtDesc c; int tl;
            if (t < CVT_T1)      { c = CvtDesc{p.in[12], (bf16_t*)(ws + WS_WINE), DM, NE_SRC, NE, 0}; tl = t - CVT_T0; }
            else if (t < CVT_T2) { c = CvtDesc{p.in[29], (bf16_t*)(ws + WS_WINO), DM, NO_SRC, NO, 1}; tl = t - CVT_T1; }
            else if (t < CVT_T3) { c = CvtDesc{p.in[13], (bf16_t*)(ws + WS_WOUT0), DM, DM, DM, 0}; tl = t - CVT_T2; }
            else if (t < CVT_T4) { c = CvtDesc{p.in[30], (bf16_t*)(ws + WS_WOUT1), DM, DM, DM, 0}; tl = t - CVT_T3; }
            else if (t < CVT_T5) { c = CvtDesc{p.in[8], (bf16_t*)(ws + WS_WUP0), DM, UPN, UPN, 0}; tl = t - CVT_T4; }
            else if (t < CVT_T6) { c = CvtDesc{p.in[8] + (size_t)DM * UPN, (bf16_t*)(ws + WS_WUP1), DM, UPN, UPN, 0}; tl = t - CVT_T5; }
            else if (t < CVT_T7) { c = CvtDesc{p.in[10], (bf16_t*)(ws + WS_WDN0), FFN, DM, DM, 0}; tl = t - CVT_T6; }
            else if (t < CVT_T8) { c = CvtDesc{p.in[10] + (size_t)FFN * DM, (bf16_t*)(ws + WS_WDN1), FFN, DM, DM, 0}; tl = t - CVT_T7; }
            else                 { c = CvtDesc{p.in[22], (bf16_t*)(ws + WS_WGLU), 512, 512, 512, 0}; tl = t - CVT_T8; }
            const int nkt = c.K / 64, tn = tl / nkt, tk = tl % nkt, n0 = tn * 256, k0 = tk * 64;
            { const int n4 = (tid & 63) * 4, kb = tid >> 6; const int sc = cvt_srccol(c.mode, n0 + n4, c.Nsrc);
              f32x4 v[8];
#pragma unroll
              for (int i = 0; i < 8; ++i) { const int k = i * 8 + kb; v[i] = (sc >= 0) ? *(const f32x4*)(c.src + (size_t)(k0 + k) * c.Nsrc + sc) : (f32x4){0.f, 0.f, 0.f, 0.f}; }
#pragma unroll
              for (int i = 0; i < 8; ++i) { const int k = i * 8 + kb; *(f32x4*)(lds + k * CVT_PITCH + n4) = v[i]; } }
            __syncthreads();
            { const int n = tid >> 1, kh = tid & 1; const float* col = lds + (kh * 32) * CVT_PITCH + n;
              bf16_t* dp = c.dst + (size_t)(n0 + n) * c.K + k0 + kh * 32;
#pragma unroll
              for (int q = 0; q < 4; ++q) { float v[8];
#pragma unroll
                  for (int i = 0; i < 8; ++i) v[i] = col[(q * 8 + i) * CVT_PITCH];
                  st8(dp + q * 8, v); } }
            __syncthreads();
        }
    }
}

__device__ void phase_modreduce(CP& p) {
    OPQ_IDS;
    const float* mp = (const float*)(p.ws + WS_MODP); float* mf = (float*)(p.ws + WS_MODF);
    for (int idx = bid_ * NTHR + tid_; idx < 2 * 5 * MODN; idx += gridDim.x * NTHR) {
        const int layer = idx / (5 * MODN), rem = idx % (5 * MODN), col = rem % MODN;
        float s = p.in[5][layer * MODN + col];
#pragma unroll
        for (int kc = 0; kc < 32; ++kc) s += mp[((size_t)(kc * 2 + layer) * 5) * MODN + rem];
        mf[idx] = s;
    }
}

__device__ void phase_norm(CP& p, int layer, int which, int nrows, bool from_input) {
    OPQ_IDS;
    const int lane = tid_ & 63, wid = tid_ >> 6;
    const float* xc = (const float*)(p.ws + WS_XC); bf16_t* act = (bf16_t*)(p.ws + WS_ACT);
    const float* nw = (which ? p.in[7] : p.in[6]) + layer * DM;
    const float* mf = (const float*)(p.ws + WS_MODF) + (size_t)layer * 5 * MODN;
    for (int row = bid_ * 8 + wid; row < nrows; row += gridDim.x * 8) {
        const float* src; int r;
        if (row < MLAT) { src = (from_input ? p.in[0] : p.out) + (size_t)row * DM; r = row >> 12; }
        else { src = (from_input ? p.in[2] : xc) + (size_t)(row - MLAT) * DM; r = 4; }
        const float* sh = mf + (size_t)r * MODN + (which ? 3 : 0) * DM; const float* sc = mf + (size_t)r * MODN + (which ? 4 : 1) * DM;
        f32x4 v[8]; float ss = 0.f;
#pragma unroll
        for (int j = 0; j < 8; ++j) { v[j] = *(const f32x4*)(src + j * 256 + lane * 4); ss += v[j][0] * v[j][0] + v[j][1] * v[j][1] + v[j][2] * v[j][2] + v[j][3] * v[j][3]; }
        ss = red64(ss);
        const float rs = rsqrtf(ss * (1.f / DM) + 1e-6f);
#pragma unroll
        for (int j = 0; j < 8; ++j) { const int col = j * 256 + lane * 4;
            const f32x4 w4 = *(const f32x4*)(nw + col), s4 = *(const f32x4*)(sh + col), c4 = *(const f32x4*)(sc + col);
            const f32x4 o = (v[j] * rs * w4) * (c4 + 1.f) + s4;
            u32x2 w; w.x = pack2(o[0], o[1]); w.y = pack2(o[2], o[3]);
            *(u32x2*)(act + (size_t)row * DM + col) = w; }
    }
}
__device__ void phase_final_norm(CP& p) {
    OPQ_IDS;
    const int lane = tid_ & 63, wid = tid_ >> 6;
    const float* nw = p.in[11];
    for (int row = bid_ * 8 + wid; row < MLAT; row += gridDim.x * 8) {
        float* src = p.out + (size_t)row * DM;
        f32x4 v[8]; float ss = 0.f;
#pragma unroll
        for (int j = 0; j < 8; ++j) { v[j] = *(const f32x4*)(src + j * 256 + lane * 4); ss += v[j][0] * v[j][0] + v[j][1] * v[j][1] + v[j][2] * v[j][2] + v[j][3] * v[j][3]; }
        ss = red64(ss);
        const float rs = rsqrtf(ss * (1.f / DM) + 1e-6f);
#pragma unroll
        for (int j = 0; j < 8; ++j) { const int col = j * 256 + lane * 4; const f32x4 w4 = *(const f32x4*)(nw + col); *(f32x4*)(src + col) = v[j] * rs * w4; }
    }
}

__device__ void phase_ffnconv(CP& p, int layer, int nrows) {
    OPQ_IDS;
    bf16_t* big = (bf16_t*)(p.ws + WS_BIG);
    const float* cw = p.in[9] + (size_t)layer * 9 * FFN;
    const int nseg = nrows / 32; constexpr int NCG = FFN / 8;
    struct F8 { f32x4 lo, hi; };
    for (long it = (long)bid_ * NTHR + tid_; it < (long)nseg * NCG; it += (long)gridDim.x * NTHR) {
        const int seg = (int)(it / NCG), cgp = (int)(it % NCG), c0 = cgp * 8, row0 = seg * 32;
        const bool lat = row0 < MLAT;
        const int W = lat ? 64 : 256;
        const int x0 = lat ? (row0 & 63) : ((row0 - MLAT) & 255);
        const int y = lat ? ((row0 & 4095) >> 6) : 0;
        const bool up_ok = lat && y > 0, dn_ok = lat && y < 63;
        F8 w[9];
#pragma unroll
        for (int q = 0; q < 9; ++q) { w[q].lo = *(const f32x4*)(cw + (size_t)q * FFN + c0); w[q].hi = *(const f32x4*)(cw + (size_t)q * FFN + c0 + 4); }
        F8 L[3], M[3], R[3];
        auto ldcol = [&](int row, bool ok, F8 (&dst)[3]) {
#pragma unroll
            for (int dy = 0; dy < 3; ++dy) {
                const bool rok = ok && (dy == 1 || (dy == 0 ? up_ok : dn_ok));
                if (rok) { const u32x4 raw = *(const u32x4*)(big + (size_t)(row + (dy - 1) * 64) * UPN + c0);
                    dst[dy].lo = (f32x4){lo16(raw.x), hi16(raw.x), lo16(raw.y), hi16(raw.y)}; dst[dy].hi = (f32x4){lo16(raw.z), hi16(raw.z), lo16(raw.w), hi16(raw.w)}; }
                else { dst[dy].lo = (f32x4){0.f, 0.f, 0.f, 0.f}; dst[dy].hi = (f32x4){0.f, 0.f, 0.f, 0.f}; }
            }
        };
        ldcol(row0 - 1, x0 > 0, L);
        ldcol(row0, true, M);
#pragma unroll 4
        for (int i = 0; i < 32; ++i) {
            const int row = row0 + i;
            ldcol(row + 1, (x0 + i + 1) < W, R);
            f32x4 a = (f32x4){0.f, 0.f, 0.f, 0.f}, bq = (f32x4){0.f, 0.f, 0.f, 0.f};
#pragma unroll
            for (int dy = 0; dy < 3; ++dy) { a += L[dy].lo * w[dy * 3 + 0].lo + M[dy].lo * w[dy * 3 + 1].lo + R[dy].lo * w[dy * 3 + 2].lo;
                bq += L[dy].hi * w[dy * 3 + 0].hi + M[dy].hi * w[dy * 3 + 1].hi + R[dy].hi * w[dy * 3 + 2].hi; }
            bf16_t* vp = big + (size_t)row * UPN + FFN + c0;
            const u32x4 vraw = *(const u32x4*)vp;
            u32x4 o;
            o.x = pack2(siluf_(a[0]) * lo16(vraw.x), siluf_(a[1]) * hi16(vraw.x)); o.y = pack2(siluf_(a[2]) * lo16(vraw.y), siluf_(a[3]) * hi16(vraw.y));
            o.z = pack2(siluf_(bq[0]) * lo16(vraw.z), siluf_(bq[1]) * hi16(vraw.z)); o.w = pack2(siluf_(bq[2]) * lo16(vraw.w), siluf_(bq[3]) * hi16(vraw.w));
            *(u32x4*)vp = o;
#pragma unroll
            for (int dy = 0; dy < 3; ++dy) { L[dy] = M[dy]; M[dy] = R[dy]; }
        }
    }
}

__device__ __forceinline__ int seg_len(int seg) { return seg ? SEQ : CTXL; }
__device__ __forceinline__ int seg_base(int seg, int b) { return seg ? b * SEQ : MLAT + b * CTXL; }

template <bool CONV, int NI = 10> struct StageRaw { u32x2 x0[NI]; u32x2 xm[CONV ? NI : 1]; u32x2 xp[CONV ? NI : 1]; };
__device__ __forceinline__ void chunk_pos(int cidx, int b, int& len, int& rowbase, int& c0) { if (cidx < 4) { len = CTXL; rowbase = MLAT + b * CTXL; c0 = cidx * 64; } else { len = SEQ; rowbase = b * SEQ; c0 = (cidx - 4) * 64; } }
template <bool CONV, int NI, class ColMap>
__device__ __forceinline__ void stage_load(StageRaw<CONV, NI>& r, const bf16_t* proj, int ldp, int rowbase, int len, int c0, int d, ColMap colmap, int tid_) {
    constexpr int NQ = NI * 8;
    asm volatile("" : "+v"(tid_));
#pragma unroll
    for (int k = 0; k < NI; ++k) {
        const int it = tid_ + k * NTHR, i = it / NQ, ch = (it % NQ) * 4;
        const int pi = c0 + i, t = d ? (len - 1 - pi) : pi;
        const bf16_t* pp = proj + (size_t)(rowbase + t) * ldp + colmap(ch);
        r.x0[k] = *(const u32x2*)pp;
        if (CONV) { r.xm[k] = *(const u32x2*)(pp - (t > 0 ? ldp : 0)); r.xp[k] = *(const u32x2*)(pp + (t < len - 1 ? ldp : 0)); }
    }
}
template <bool CONV, int NI>
__device__ __forceinline__ f32x4 stage_value(const StageRaw<CONV, NI>& r, int k, int i, int ch, int len, int c0, int d, const float* scw, const float* scb) {
    constexpr int NCH = NI * 32;
    const u32x2 x0 = r.x0[k];
    const f32x4 f0 = (f32x4){lo16(x0.x), hi16(x0.x), lo16(x0.y), hi16(x0.y)};
    if (!CONV) return f0;
    const int pi = c0 + i, t = d ? (len - 1 - pi) : pi;
    const bool mok = (t > 0), pok = (t < len - 1);
    const u32x2 xm = r.xm[k], xp = r.xp[k];
    const f32x4 fm = mok ? (f32x4){lo16(xm.x), hi16(xm.x), lo16(xm.y), hi16(xm.y)} : (f32x4){0.f, 0.f, 0.f, 0.f};
    const f32x4 fp = pok ? (f32x4){lo16(xp.x), hi16(xp.x), lo16(xp.y), hi16(xp.y)} : (f32x4){0.f, 0.f, 0.f, 0.f};
    f32x4 v = *(const f32x4*)(scb + ch) + *(const f32x4*)(scw + ch) * fm + *(const f32x4*)(scw + NCH + ch) * f0 + *(const f32x4*)(scw + 2 * NCH + ch) * fp;
    v[0] = siluf_(v[0]); v[1] = siluf_(v[1]); v[2] = siluf_(v[2]); v[3] = siluf_(v[3]);
    return v;
}
template <bool CONV, int NI>
__device__ __forceinline__ void stage_store(const StageRaw<CONV, NI>& r, int len, int c0, int d, const float* scw, const float* scb, float* srow, int tid_) {
    constexpr int NQ = NI * 8, NCH = NI * 32;
    asm volatile("" : "+v"(tid_));
#pragma unroll
    for (int k = 0; k < NI; ++k) {
        const int it = tid_ + k * NTHR, i = it / NQ, ch = (it % NQ) * 4;
        *(f32x4*)(srow + i * NCH + ch) = stage_value<CONV, NI>(r, k, i, ch, len, c0, d, scw, scb);
    }
}

__device__ void scan_ssd(CP& p, unsigned char* shm, int id) {
    OPQ_IDS;
    const int tid = tid_;
    const int b = id / 48, rem = id % 48, h = rem >> 1, d = rem & 1, g = h / 6;
    float* srow = (float*)shm;
    float* scw = srow + 64 * 320;
    float* scb = scw + 3 * 320;
    float* sdt = scb + 320;
    float* sdec = sdt + 64;
    float* sout = sdec + 64;
    const bf16_t* proj = (const bf16_t*)(p.ws + WS_BIG);
    const float* gates = (const float*)(p.ws + WS_GATES);
    bf16_t* yd = (bf16_t*)(p.ws + WS_BIG + BIG_PROJ) + (size_t)d * MTOT * DM;
    auto colmap = [=](int ch) { return ch < 64 ? (2048 + h * 64 + ch) : (ch < 192 ? (3584 + g * 128 + (ch - 64)) : (4096 + g * 128 + (ch - 192))); };
    for (int e = tid; e < 320; e += NTHR) { const int cc = colmap(e) - 2048;
        scw[e] = p.in[23][cc]; scw[320 + e] = p.in[23][2560 + cc]; scw[640 + e] = p.in[23][2 * 2560 + cc]; scb[e] = p.in[24][cc]; }
    const float dtb = p.in[25][d * 24 + h], aneg = -expf(p.in[26][d * 24 + h]);
    const int ns = tid & 15, pp = tid >> 4;
    float s0[8], s1[8];
#pragma unroll
    for (int j = 0; j < 8; ++j) { s0[j] = 0.f; s1[j] = 0.f; }
    __syncthreads();
    StageRaw<true, 10> raw; float graw = 0.f;
    { int len, rowbase, c0; chunk_pos(0, b, len, rowbase, c0); stage_load<true, 10>(raw, proj, NE_MAIN, rowbase, len, c0, d, colmap, tid_);
      if (tid_ < 64) { const int pi = c0 + tid_, t = d ? (len - 1 - pi) : pi; graw = gates[(size_t)(rowbase + t) * 64 + d * 24 + h]; } }
    for (int cidx = 0; cidx < 68; ++cidx) {
        int len, rowbase, c0; chunk_pos(cidx, b, len, rowbase, c0);
        {
            stage_store<true, 10>(raw, len, c0, d, scw, scb, srow, tid_);
            if (tid_ < 64) { const float dt = softplusf_(graw + dtb); sdt[tid_] = dt; sdec[tid_] = expf(dt * aneg); }
            __syncthreads();
            if (cidx + 1 < 68) { int len2, rowbase2, c02; chunk_pos(cidx + 1, b, len2, rowbase2, c02); stage_load<true, 10>(raw, proj, NE_MAIN, rowbase2, len2, c02, d, colmap, tid_);
                if (tid_ < 64) { const int pi = c02 + tid_, t = d ? (len2 - 1 - pi) : pi; graw = gates[(size_t)(rowbase2 + t) * 64 + d * 24 + h]; } }
            {
                const float* rp0 = srow;
                float dec_n = sdec[0], dtv_n = sdt[0]; float2 xv_n = *(const float2*)(rp0 + 2 * pp);
                f32x4 B0n = *(const f32x4*)(rp0 + 64 + ns * 8), B1n = *(const f32x4*)(rp0 + 64 + ns * 8 + 4), C0n = *(const f32x4*)(rp0 + 192 + ns * 8), C1n = *(const f32x4*)(rp0 + 192 + ns * 8 + 4);
                for (int i = 0; i < 64; ++i) {
                    const float dec = dec_n, dtv = dtv_n; const float2 xv = xv_n; const f32x4 B0 = B0n, B1 = B1n, C0 = C0n, C1 = C1n;
                    if (i < 63) { const float* rp = srow + (i + 1) * 320; dec_n = sdec[i + 1]; dtv_n = sdt[i + 1]; xv_n = *(const float2*)(rp + 2 * pp);
                        B0n = *(const f32x4*)(rp + 64 + ns * 8); B1n = *(const f32x4*)(rp + 64 + ns * 8 + 4); C0n = *(const f32x4*)(rp + 192 + ns * 8); C1n = *(const f32x4*)(rp + 192 + ns * 8 + 4); }
                    const float x0 = xv.x * dtv, x1 = xv.y * dtv;
                    float y0a = 0.f, y0b = 0.f, y1a = 0.f, y1b = 0.f;
#pragma unroll
                    for (int j = 0; j < 4; ++j) {
                        s0[j] = s0[j] * dec + x0 * B0[j]; s1[j] = s1[j] * dec + x1 * B0[j]; y0a += s0[j] * C0[j]; y1a += s1[j] * C0[j];
                        s0[4 + j] = s0[4 + j] * dec + x0 * B1[j]; s1[4 + j] = s1[4 + j] * dec + x1 * B1[j]; y0b += s0[4 + j] * C1[j]; y1b += s1[4 + j] * C1[j]; }
                    const float y0 = red16(y0a + y0b), y1 = red16(y1a + y1b);
                    if (ns == 0) *(float2*)(sout + i * 64 + 2 * pp) = make_float2(y0, y1);
                }
            }
            __syncthreads();
            { const int i = tid_ >> 3, c8 = (tid_ & 7) * 8, pi = c0 + i, t = d ? (len - 1 - pi) : pi; float o[8]; ldf8(sout + i * 64 + c8, o);
              st8(yd + (size_t)(rowbase + t) * DM + 512 + h * 64 + c8, o); }
        }
    }
}

__device__ void scan_s5(CP& p, unsigned char* shm, int id2) {
    OPQ_IDS;
    const int tid = tid_, sl = tid >> 7, j = tid & 127, st = j >> 1, part = j & 1;
    const int s = id2 * 4 + sl, b = s >> 6, rem = s & 63, g = rem >> 1, d = rem & 1;
    float* su = (float*)shm + sl * (32 * 16);
    float* sX = (float*)shm + 4 * 32 * 16 + sl * (32 * 132);
    float* sC = (float*)shm + 4 * 32 * 16 + 4 * 32 * 132 + sl * (128 * 16);
    const bf16_t* proj = (const bf16_t*)(p.ws + WS_BIG);
    bf16_t* yd = (bf16_t*)(p.ws + WS_BIG + BIG_PROJ) + (size_t)d * MTOT * DM;
    const int dg = d * 32 + g;
    const float lr = p.in[14][dg * 64 + st], li = p.in[15][dg * 64 + st], step = expf(p.in[16][dg]);
    const float ea = lr * step, eb = li * step, mag = expf(ea), cb = cosf(eb), sb = sinf(eb), shb = sinf(0.5f * eb);
    const float lbr = mag * cb, lbi = mag * sb;
    const float nr = expm1f(ea) * cb - 2.f * shb * shb, ni = lbi;
    const float den = lr * lr + li * li;
    const float qr = (nr * lr + ni * li) / den, qi = (ni * lr - nr * li) / den;
    float Bb[16];
#pragma unroll
    for (int hh = 0; hh < 16; ++hh) { const float br = p.in[17][(size_t)(dg * 64 + st) * 16 + hh], bi = p.in[18][(size_t)(dg * 64 + st) * 16 + hh];
        Bb[hh] = part ? (qr * bi + qi * br) : (qr * br - qi * bi); }
#pragma unroll
    for (int hh = 0; hh < 16; ++hh) sC[j * 16 + hh] = part ? -p.in[20][(size_t)(dg * 16 + hh) * 64 + st] : p.in[19][(size_t)(dg * 16 + hh) * 64 + st];
    const float lis = part ? lbi : -lbi;
    float x = 0.f;
    __syncthreads();
    for (int seg = 0; seg < 2; ++seg) {
        const int len = seg_len(seg), rowbase = seg_base(seg, b);
        for (int c0 = 0; c0 < len; c0 += 32) {
            { const int i = j >> 2, hq = j & 3, pi = c0 + i, t = d ? (len - 1 - pi) : pi;
              const u32x2 raw = *(const u32x2*)(proj + (size_t)(rowbase + t) * NE_MAIN + g * 16 + hq * 4);
              *(f32x4*)(su + i * 16 + hq * 4) = (f32x4){lo16(raw.x), hi16(raw.x), lo16(raw.y), hi16(raw.y)}; }
            __syncthreads();
            for (int i = 0; i < 32; ++i) {
                const f32x4 u0 = *(const f32x4*)(su + i * 16), u1 = *(const f32x4*)(su + i * 16 + 4), u2 = *(const f32x4*)(su + i * 16 + 8), u3 = *(const f32x4*)(su + i * 16 + 12);
                float bu = 0.f;
#pragma unroll
                for (int q = 0; q < 4; ++q) bu += Bb[q] * u0[q] + Bb[4 + q] * u1[q] + Bb[8 + q] * u2[q] + Bb[12 + q] * u3[q];
                const float xp = dppmov<0xB1>(x);
                x = lbr * x + lis * xp + bu;
                sX[i * 132 + j] = x;
            }
            __syncthreads();
            { const int i = j >> 2, hq = j & 3, pi = c0 + i, t = d ? (len - 1 - pi) : pi;
              f32x4 acc = (f32x4){0.f, 0.f, 0.f, 0.f};
              for (int jj = 0; jj < 128; jj += 4) { const f32x4 xv = *(const f32x4*)(sX + i * 132 + jj);
#pragma unroll
                  for (int q = 0; q < 4; ++q) acc += *(const f32x4*)(sC + (jj + q) * 16 + hq * 4) * xv[q]; }
              u32x2 o; o.x = pack2(acc[0], acc[1]); o.y = pack2(acc[2], acc[3]);
              *(u32x2*)(yd + (size_t)(rowbase + t) * DM + g * 16 + hq * 4) = o; }
        }
    }
}

__device__ void scan_gdn(CP& p, unsigned char* shm, int id) {
    OPQ_IDS;
    const int tid = tid_, lane = tid & 63, wid = tid >> 6;
    const int b = id >> 5, rem = id & 31, h = rem >> 2, d = (rem >> 1) & 1, vh = rem & 1;
    float* srow = (float*)shm;
    float* scw = srow + 64 * 320;
    float* scb = scw + 3 * 320;
    float* srq = scb + 320;
    float* srk = srq + 64;
    float* sa = srk + 64;
    float* sbt = sa + 64;
    float* sout = sbt + 64;
    const bf16_t* proj = (const bf16_t*)(p.ws + WS_BIG);
    const float* gates = (const float*)(p.ws + WS_GATES);
    bf16_t* yd = (bf16_t*)(p.ws + WS_BIG + BIG_PROJ) + (size_t)d * MTOT * DM;
    auto colmap = [=](int ch) { return ch < 128 ? (h * 128 + ch) : (ch < 256 ? (1024 + h * 128 + (ch - 128)) : (2048 + h * 128 + vh * 64 + (ch - 256))); };
    for (int e = tid; e < 320; e += NTHR) { const int cc = colmap(e);
        scw[e] = p.in[31][cc]; scw[320 + e] = p.in[31][3072 + cc]; scw[640 + e] = p.in[31][2 * 3072 + cc]; scb[e] = 0.f; }
    const float dtb = p.in[32][d * 8 + h], aexp = -expf(p.in[33][d * 8 + h]);
    const int ks = tid & 7, col = tid >> 3;
    float S[16];
#pragma unroll
    for (int jx = 0; jx < 16; ++jx) S[jx] = 0.f;
    __syncthreads();
    StageRaw<true, 10> raw; float graw0 = 0.f, graw1 = 0.f;
    { int len, rowbase, c0; chunk_pos(0, b, len, rowbase, c0); stage_load<true, 10>(raw, proj, NO_MAIN, rowbase, len, c0, d, colmap, tid_);
      if (tid_ < 64) { const int pi = c0 + tid_, t = d ? (len - 1 - pi) : pi; const float* gp = gates + (size_t)(rowbase + t) * 64; graw0 = gp[d * 8 + h]; graw1 = gp[16 + d * 8 + h]; } }
    for (int cidx = 0; cidx < 68; ++cidx) {
        int len, rowbase, c0; chunk_pos(cidx, b, len, rowbase, c0);
        {
            stage_store<true, 10>(raw, len, c0, d, scw, scb, srow, tid_);
            if (tid_ < 64) { sbt[tid_] = sigmoidf_(graw0); sa[tid_] = expf(aexp * softplusf_(graw1 + dtb)); }
            __syncthreads();
            if (cidx + 1 < 68) { int len2, rowbase2, c02; chunk_pos(cidx + 1, b, len2, rowbase2, c02); stage_load<true, 10>(raw, proj, NO_MAIN, rowbase2, len2, c02, d, colmap, tid_);
                if (tid_ < 64) { const int pi = c02 + tid_, t = d ? (len2 - 1 - pi) : pi; const float* gp = gates + (size_t)(rowbase2 + t) * 64; graw0 = gp[d * 8 + h]; graw1 = gp[16 + d * 8 + h]; } }
            for (int i = wid; i < 64; i += 8) { const float* rp = srow + i * 320;
                float q2 = rp[lane] * rp[lane] + rp[64 + lane] * rp[64 + lane], k2 = rp[128 + lane] * rp[128 + lane] + rp[192 + lane] * rp[192 + lane];
                q2 = red64(q2); k2 = red64(k2);
                if (lane == 0) { srq[i] = rsqrtf(q2 + 1e-6f) * 0.08838834764831845f; srk[i] = rsqrtf(k2 + 1e-6f); } }
            __syncthreads();
            {
                float a_n = sa[0], bt_n = sbt[0], rk_n = srk[0], rq_n = srq[0], vv_n = srow[256 + col];
                f32x4 kkn[4], qqn[4];
#pragma unroll
                for (int q = 0; q < 4; ++q) { kkn[q] = *(const f32x4*)(srow + 128 + ks * 16 + q * 4); qqn[q] = *(const f32x4*)(srow + ks * 16 + q * 4); }
                for (int i = 0; i < 64; ++i) {
                    const float a = a_n, bt = bt_n, rk = rk_n, rq = rq_n, vv = vv_n;
                    f32x4 kk[4], qq[4];
#pragma unroll
                    for (int q = 0; q < 4; ++q) { kk[q] = kkn[q]; qq[q] = qqn[q]; }
                    if (i < 63) { const float* rp = srow + (i + 1) * 320; a_n = sa[i + 1]; bt_n = sbt[i + 1]; rk_n = srk[i + 1]; rq_n = srq[i + 1]; vv_n = rp[256 + col];
#pragma unroll
                        for (int q = 0; q < 4; ++q) { kkn[q] = *(const f32x4*)(rp + 128 + ks * 16 + q * 4); qqn[q] = *(const f32x4*)(rp + ks * 16 + q * 4); } }
                    float dq[4];
#pragma unroll
                    for (int q = 0; q < 4; ++q) dq[q] = kk[q][0] * S[q * 4] + kk[q][1] * S[q * 4 + 1] + kk[q][2] * S[q * 4 + 2] + kk[q][3] * S[q * 4 + 3];
                    const float dd = red8((dq[0] + dq[1]) + (dq[2] + dq[3])) * rk;
                    const float w = bt * (vv - a * dd) * rk;
                    float oq[4];
#pragma unroll
                    for (int q = 0; q < 4; ++q) {
#pragma unroll
                        for (int e = 0; e < 4; ++e) S[q * 4 + e] = a * S[q * 4 + e] + kk[q][e] * w;
                        oq[q] = qq[q][0] * S[q * 4] + qq[q][1] * S[q * 4 + 1] + qq[q][2] * S[q * 4 + 2] + qq[q][3] * S[q * 4 + 3]; }
                    const float o = red8((oq[0] + oq[1]) + (oq[2] + oq[3])) * rq;
                    if (ks == 0) sout[i * 64 + col] = o;
                }
            }
            __syncthreads();
            { const int i = tid_ >> 3, c8 = (tid_ & 7) * 8, pi = c0 + i, t = d ? (len - 1 - pi) : pi; float o[8]; ldf8(sout + i * 64 + c8, o);
              st8(yd + (size_t)(rowbase + t) * DM + h * 128 + vh * 64 + c8, o); }
        }
    }
}

__device__ void scan_mlstm(CP& p, unsigned char* shm, int id) {
    OPQ_IDS;
    const int tid = tid_, lane = tid & 63, wid = tid >> 6;
    const int b = id >> 5, rem = id & 31, h = rem >> 3, d = (rem >> 2) & 1, vq = rem & 3;
    float* srow = (float*)shm;
    float* sf = srow + 64 * 320;
    float* se = sf + 64;
    float* sout = se + 64;
    float* sden = sout + 64 * 64;
    const bf16_t* proj = (const bf16_t*)(p.ws + WS_BIG);
    const float* gates = (const float*)(p.ws + WS_GATES);
    bf16_t* yd = (bf16_t*)(p.ws + WS_BIG + BIG_PROJ) + (size_t)d * MTOT * DM;
    float* den = (float*)(p.ws + WS_DEN) + (size_t)d * MTOT * 4;
    auto colmap = [=](int ch) { return ch < 128 ? (4096 + h * 128 + ch) : (ch < 256 ? (4608 + h * 128 + (ch - 128)) : (5120 + h * 256 + vq * 64 + (ch - 256))); };
    const float ib = p.in[35][d * 4 + h], fb = p.in[36][d * 4 + h];
    const int ks = tid & 7, col = tid >> 3;
    const bool do_den = (vq == 0) && (wid == 0);
    float C[16];
#pragma unroll
    for (int jx = 0; jx < 16; ++jx) C[jx] = 0.f;
    float n0 = 0.f, n1 = 0.f;
    const float ksc = 0.08838834764831845f;
    StageRaw<false, 10> raw; float graw0 = 0.f, graw1 = 0.f;
    { int len, rowbase, c0; chunk_pos(0, b, len, rowbase, c0); stage_load<false, 10>(raw, proj, NO_MAIN, rowbase, len, c0, d, colmap, tid_);
      if (tid_ < 64) { const int pi = c0 + tid_, t = d ? (len - 1 - pi) : pi; const float* gp = gates + (size_t)(rowbase + t) * 64; graw0 = gp[32 + d * 4 + h]; graw1 = gp[40 + d * 4 + h]; } }
    for (int cidx = 0; cidx < 68; ++cidx) {
        int len, rowbase, c0; chunk_pos(cidx, b, len, rowbase, c0);
        {
            stage_store<false, 10>(raw, len, c0, d, (const float*)nullptr, (const float*)nullptr, srow, tid_);
            if (tid_ < 64) { se[tid_] = expf(graw0 + ib); sf[tid_] = sigmoidf_(graw1 + fb); }
            __syncthreads();
            if (cidx + 1 < 68) { int len2, rowbase2, c02; chunk_pos(cidx + 1, b, len2, rowbase2, c02); stage_load<false, 10>(raw, proj, NO_MAIN, rowbase2, len2, c02, d, colmap, tid_);
                if (tid_ < 64) { const int pi = c02 + tid_, t = d ? (len2 - 1 - pi) : pi; const float* gp = gates + (size_t)(rowbase2 + t) * 64; graw0 = gp[32 + d * 4 + h]; graw1 = gp[40 + d * 4 + h]; } }
            {
                float f_n = sf[0], ei_n = se[0] * ksc, vv_n = srow[256 + col];
                f32x4 kkn[4], qqn[4];
#pragma unroll
                for (int q = 0; q < 4; ++q) { kkn[q] = *(const f32x4*)(srow + 128 + ks * 16 + q * 4); qqn[q] = *(const f32x4*)(srow + ks * 16 + q * 4); }
                for (int i = 0; i < 64; ++i) {
                    const float f = f_n, ei = ei_n, vv = vv_n;
                    f32x4 kk[4], qq[4];
#pragma unroll
                    for (int q = 0; q < 4; ++q) { kk[q] = kkn[q]; qq[q] = qqn[q]; }
                    const float* rpc = srow + i * 320;
                    if (i < 63) { const float* rp = srow + (i + 1) * 320; f_n = sf[i + 1]; ei_n = se[i + 1] * ksc; vv_n = rp[256 + col];
#pragma unroll
                        for (int q = 0; q < 4; ++q) { kkn[q] = *(const f32x4*)(rp + 128 + ks * 16 + q * 4); qqn[q] = *(const f32x4*)(rp + ks * 16 + q * 4); } }
                    const float w = ei * vv;
                    float oq[4];
#pragma unroll
                    for (int q = 0; q < 4; ++q) {
#pragma unroll
                        for (int e = 0; e < 4; ++e) C[q * 4 + e] = f * C[q * 4 + e] + kk[q][e] * w;
                        oq[q] = qq[q][0] * C[q * 4] + qq[q][1] * C[q * 4 + 1] + qq[q][2] * C[q * 4 + 2] + qq[q][3] * C[q * 4 + 3]; }
                    const float o = red8((oq[0] + oq[1]) + (oq[2] + oq[3]));
                    if (ks == 0) sout[i * 64 + col] = o;
                    if (do_den) {
                        const float2 k2 = *(const float2*)(rpc + 128 + 2 * lane), q2 = *(const float2*)(rpc + 2 * lane);
                        n0 = f * n0 + ei * k2.x; n1 = f * n1 + ei * k2.y;
                        float dn = q2.x * n0 + q2.y * n1;
                        dn = red64(dn);
                        if (lane == 0) sden[i] = dn;
                    }
                }
            }
            __syncthreads();
            { const int i = tid_ >> 3, c8 = (tid_ & 7) * 8, pi = c0 + i, t = d ? (len - 1 - pi) : pi; float o[8]; ldf8(sout + i * 64 + c8, o);
              st8(yd + (size_t)(rowbase + t) * DM + 1024 + h * 256 + vq * 64 + c8, o);
              if (vq == 0 && tid_ < 64) { const int pj = c0 + tid_, tj = d ? (len - 1 - pj) : pj; den[(size_t)(rowbase + tj) * 4 + h] = sden[tid_]; } }
        }
    }
}

constexpr int LQ = 136, LT = 72, PV = 88;
typedef short s16x4 __attribute__((ext_vector_type(4)));
__device__ __forceinline__ bf16x8 ldfrag(const bf16_t* base, int row0, int ks, int ld, int fr, int fq) { return *(const bf16x8*)(base + (row0 + fr) * ld + ks * 32 + fq * 8); }
__device__ __forceinline__ bf16x8 ldfrag_tr(const bf16_t* base, int krow0, int col0, int ld, int fr) {
    const bf16_t* a = base + (krow0 + (fr >> 2)) * ld + col0 + (fr & 3) * 4;
    const s16x4 lo = __builtin_amdgcn_ds_read_tr16_b64_v4i16((LAS s16x4*)a);
    const s16x4 hi = __builtin_amdgcn_ds_read_tr16_b64_v4i16((LAS s16x4*)(a + 4 * ld));
    return (bf16x8){lo[0], lo[1], lo[2], lo[3], hi[0], hi[1], hi[2], hi[3]};
}
__device__ __forceinline__ float softplus_fast(float x) { return fmaxf(x, 0.f) + __logf(1.f + __expf(-fabsf(x))); }
struct SsdRaw { u32x2 x0[2], xm[2], xp[2], bc[8]; };
__device__ __forceinline__ void ssd_load(SsdRaw& r, const bf16_t* proj, const bf16_t* bcbuf, int rowbase, int len, int c0, int d, int h, int g, int tid_) {
    asm volatile("" : "+v"(tid_));
#pragma unroll
    for (int k = 0; k < 2; ++k) { const int it = tid_ + k * NTHR, i = it >> 4, ch = (it & 15) * 4, pi = c0 + i, t = d ? (len - 1 - pi) : pi;
        const bf16_t* pp = proj + (size_t)(rowbase + t) * NE_MAIN + 2048 + h * 64 + ch;
        r.x0[k] = *(const u32x2*)pp; r.xm[k] = *(const u32x2*)(pp - (t > 0 ? NE_MAIN : 0)); r.xp[k] = *(const u32x2*)(pp + (t < len - 1 ? NE_MAIN : 0)); }
#pragma unroll
    for (int k = 0; k < 8; ++k) { const int it = tid_ + k * NTHR, i = it >> 6, ch = (it & 63) * 4, pi = c0 + i, t = d ? (len - 1 - pi) : pi;
        r.bc[k] = *(const u32x2*)(bcbuf + (size_t)(rowbase + t) * 1024 + (ch < 128 ? (g * 128 + ch) : (512 + g * 128 + (ch - 128)))); }
}
__device__ void ssd_bc_prepass(CP& p) {
    OPQ_IDS;
    const int lane = tid_ & 63, wid = tid_ >> 6;
    const bf16_t* proj = (const bf16_t*)(p.ws + WS_BIG); bf16_t* bc = (bf16_t*)(p.ws + WS_ACT);
    for (int row = bid_ * 8 + wid; row < MTOT; row += gridDim.x * 8) {
        int t, len;
        if (row < MLAT) { t = row & (SEQ - 1); len = SEQ; } else { t = (row - MLAT) & (CTXL - 1); len = CTXL; }
        const bf16_t* pr = proj + (size_t)row * NE_MAIN + 3584;
#pragma unroll
        for (int ps = 0; ps < 2; ++ps) { const int c = ps * 512 + lane * 8, cc = 1536 + c;
            float x0[8], xm[8], xp[8], w0[8], w1[8], w2[8], cb[8], o[8];
            ld8(pr + c, x0);
            if (t > 0) ld8(pr - NE_MAIN + c, xm); else { for (int q = 0; q < 8; ++q) xm[q] = 0.f; }
            if (t < len - 1) ld8(pr + NE_MAIN + c, xp); else { for (int q = 0; q < 8; ++q) xp[q] = 0.f; }
            ldf8(p.in[23] + cc, w0); ldf8(p.in[23] + 2560 + cc, w1); ldf8(p.in[23] + 5120 + cc, w2); ldf8(p.in[24] + cc, cb);
#pragma unroll
            for (int q = 0; q < 8; ++q) o[q] = siluf_(cb[q] + w0[q] * xm[q] + w1[q] * x0[q] + w2[q] * xp[q]);
            st8(bc + (size_t)row * 1024 + c, o); }
    }
}
template <int NVT, bool IS_SSD, int VW>
__device__ void scan_la(CP& p, unsigned char* shm, int id) {
    OPQ_IDS;
    const int lane = tid_ & 63, wid = tid_ >> 6, fr = lane & 15, fq = lane >> 4;
    int b, h, d, g = 0, vq = 0;
    if (IS_SSD) { b = id / 48; const int rem = id % 48; h = rem >> 1; d = rem & 1; g = h / 6; }
    else if (VW == 64) { b = id >> 5; const int rem = id & 31; h = rem >> 3; d = (rem >> 2) & 1; vq = rem & 3; }
    else { b = id >> 6; const int rem = id & 63; h = rem >> 4; d = (rem >> 3) & 1; vq = rem & 7; }
    bf16_t* sQ = (bf16_t*)shm;
    bf16_t* sK = sQ + 64 * LQ;
    bf16_t* sV = sK + 64 * LQ;
    bf16_t* sVw = sV + 64 * PV;
    bf16_t* sP = sVw + 64 * PV;
    bf16_t* sS = sP + 64 * LT;
    float* sout = (float*)(sS + 80 * LQ);
    float* scw = sout + 4096;
    float* scb = scw + 960;
    float* scum = scb + 320;
    float* sw = scum + 64;
    float* se = sw + 64;
    float* sden = se + 64;
    const bf16_t* proj = (const bf16_t*)(p.ws + WS_BIG);
    const float* gates = (const float*)(p.ws + WS_GATES);
    bf16_t* yd = (bf16_t*)(p.ws + WS_BIG + BIG_PROJ) + (size_t)d * MTOT * DM;
    float* den = (float*)(p.ws + WS_DEN) + (size_t)d * MTOT * 4;
    const int ldp = IS_SSD ? NE_MAIN : NO_MAIN;
    auto colmap = [=](int ch) { return IS_SSD ? (ch < 64 ? (2048 + h * 64 + ch) : (ch < 192 ? (3584 + g * 128 + (ch - 64)) : (4096 + g * 128 + (ch - 192))))
                                              : (ch < VW ? (5120 + h * 256 + vq * VW + ch) : (ch < VW + 128 ? (4608 + h * 128 + (ch - VW)) : (4096 + h * 128 + (ch - VW - 128)))); };
    if (IS_SSD) for (int e = tid_; e < 320; e += NTHR) { const int cc = colmap(e) - 2048;
        scw[e] = p.in[23][cc]; scw[320 + e] = p.in[23][2560 + cc]; scw[640 + e] = p.in[23][2 * 2560 + cc]; scb[e] = p.in[24][cc]; }
    for (int e = tid_; e < 80 * LQ; e += NTHR) sS[e] = 0;
    for (int e = tid_; e < 64 * 24; e += NTHR) { const int i = e / 24, c = VW + e % 24; sV[i * PV + c] = (c == VW) ? (bf16_t)0x3F80 : (bf16_t)0; sVw[i * PV + c] = 0; }
    float g0b, g1b;
    if (IS_SSD) { g0b = p.in[25][d * 24 + h]; g1b = -expf(p.in[26][d * 24 + h]); }
    else { g0b = p.in[35][d * 4 + h]; g1b = p.in[36][d * 4 + h]; }
    const int gcol0 = IS_SSD ? (d * 24 + h) : (32 + d * 4 + h), gcol1 = IS_SSD ? (d * 24 + h) : (40 + d * 4 + h);
    f32x4 Sacc[NVT];
#pragma unroll
    for (int vt = 0; vt < NVT; ++vt) Sacc[vt] = (f32x4){0.f, 0.f, 0.f, 0.f};
    constexpr int NIM = (VW + 256) / 32;
    StageRaw<false, NIM> raw; SsdRaw sraw; float graw0 = 0.f, graw1 = 0.f;
    const bf16_t* bcbuf = (const bf16_t*)(p.ws + WS_ACT);
    static_assert(IS_SSD || (VW == 32 && NIM == 9), "mLSTM staging layout assumes 32-column v slices");
    const int mq_i0 = tid_ >> 6, mq_ch = (tid_ & 63) * 4;
    const int mq_col = (mq_ch < 128) ? (4608 + h * 128 + mq_ch) : (4096 + h * 128 + (mq_ch - 128));
    bf16_t* const mq_dst = (mq_ch < 128) ? (sK + mq_i0 * LQ + mq_ch) : (sQ + mq_i0 * LQ + (mq_ch - 128));
    const int mv_i = tid_ >> 3, mv_ch = (tid_ & 7) * 4, mv_col = 5120 + h * 256 + vq * VW + mv_ch;
    bf16_t* const mv_dst = sV + mv_i * PV + mv_ch;
    auto mload = [&](int rowbase_, int len_, int c0_) {
#pragma unroll
        for (int k = 0; k < 8; ++k) { const int pi = c0_ + mq_i0 + 8 * k, t = d ? (len_ - 1 - pi) : pi;
            raw.x0[k] = *(const u32x2*)(proj + (size_t)((rowbase_ + t) * ldp + mq_col)); }
        { const int pi = c0_ + mv_i, t = d ? (len_ - 1 - pi) : pi; raw.x0[8] = *(const u32x2*)(proj + (size_t)((rowbase_ + t) * ldp + mv_col)); }
    };
    { int len, rowbase, c0; chunk_pos(0, b, len, rowbase, c0);
      if (IS_SSD) ssd_load(sraw, proj, bcbuf, rowbase, len, c0, d, h, g, tid_); else mload(rowbase, len, c0);
      if (tid_ < 64) { const int pi = c0 + tid_, t = d ? (len - 1 - pi) : pi; const float* gp = gates + (size_t)(rowbase + t) * 64; graw0 = gp[gcol0]; graw1 = gp[gcol1]; } }
    __syncthreads();
    const int rt = wid & 3, wh = wid >> 2;
    for (int cidx = 0; cidx < 68; ++cidx) {
        int len, rowbase, c0; chunk_pos(cidx, b, len, rowbase, c0);
        if (wid == 0) {
            float lf, e;
            if (IS_SSD) { const float dt = softplus_fast(graw0 + g0b); lf = dt * g1b; e = dt; }
            else { e = __expf(graw0 + g0b) * 0.08838834764831845f; lf = -softplus_fast(-(graw1 + g1b)); }
            float c = lf;
#pragma unroll
            for (int off = 1; off < 64; off <<= 1) { const float t2 = __shfl_up(c, off, 64); if (lane >= off) c += t2; }
            const float cend = __shfl(c, 63, 64);
            const float wj = e * __expf(cend - c);
            scum[lane] = c; se[lane] = e; sw[lane] = wj;
            if (!IS_SSD) sVw[lane * PV + VW] = f2bf(wj);
        }
        __syncthreads();
        if (IS_SSD) {
            int tl = tid_; asm volatile("" : "+v"(tl));
#pragma unroll
            for (int k = 0; k < 2; ++k) {
                const int it = tl + k * NTHR, i = it >> 4, ch = (it & 15) * 4, pi = c0 + i, t = d ? (len - 1 - pi) : pi;
                const u32x2 x0 = sraw.x0[k], xm = sraw.xm[k], xp = sraw.xp[k];
                const f32x4 f0 = (f32x4){lo16(x0.x), hi16(x0.x), lo16(x0.y), hi16(x0.y)};
                const f32x4 fm = (t > 0) ? (f32x4){lo16(xm.x), hi16(xm.x), lo16(xm.y), hi16(xm.y)} : (f32x4){0.f, 0.f, 0.f, 0.f};
                const f32x4 fp = (t < len - 1) ? (f32x4){lo16(xp.x), hi16(xp.x), lo16(xp.y), hi16(xp.y)} : (f32x4){0.f, 0.f, 0.f, 0.f};
                f32x4 v = *(const f32x4*)(scb + ch) + *(const f32x4*)(scw + ch) * fm + *(const f32x4*)(scw + 320 + ch) * f0 + *(const f32x4*)(scw + 640 + ch) * fp;
                v[0] = siluf_(v[0]); v[1] = siluf_(v[1]); v[2] = siluf_(v[2]); v[3] = siluf_(v[3]);
                const float wi = sw[i];
                u32x2 w2, w3; w2.x = pack2(v[0], v[1]); w2.y = pack2(v[2], v[3]); w3.x = pack2(v[0] * wi, v[1] * wi); w3.y = pack2(v[2] * wi, v[3] * wi);
                *(u32x2*)(sV + i * PV + ch) = w2; *(u32x2*)(sVw + i * PV + ch) = w3;
            }
#pragma unroll
            for (int k = 0; k < 8; ++k) {
                const int it = tl + k * NTHR, i = it >> 6, ch = (it & 63) * 4;
                if (ch < 128) *(u32x2*)(sK + i * LQ + ch) = sraw.bc[k]; else *(u32x2*)(sQ + i * LQ + (ch - 128)) = sraw.bc[k];
            }
        } else {
#pragma unroll
            for (int k = 0; k < 8; ++k) *(u32x2*)(mq_dst + k * 8 * LQ) = raw.x0[k];
            { const u32x2 w2 = raw.x0[8]; const float wi = sw[mv_i];
              u32x2 w3; w3.x = pack2(lo16(w2.x) * wi, hi16(w2.x) * wi); w3.y = pack2(lo16(w2.y) * wi, hi16(w2.y) * wi);
              *(u32x2*)mv_dst = w2; *(u32x2*)(mv_dst + 64 * PV) = w3; }
        }
        __syncthreads();
        if (cidx + 1 < 68) { int len2, rowbase2, c02; chunk_pos(cidx + 1, b, len2, rowbase2, c02);
            if (IS_SSD) ssd_load(sraw, proj, bcbuf, rowbase2, len2, c02, d, h, g, tid_); else mload(rowbase2, len2, c02);
            if (tid_ < 64) { const int pi = c02 + tid_, t = d ? (len2 - 1 - pi) : pi; const float* gp = gates + (size_t)(rowbase2 + t) * 64; graw0 = gp[gcol0]; graw1 = gp[gcol1]; } }
        const float cend = scum[63];
        const f32x4 crow = *(const f32x4*)(scum + rt * 16 + fq * 4);
        const f32x4 erow = (f32x4){__expf(crow[0]), __expf(crow[1]), __expf(crow[2]), __expf(crow[3])};
        bf16x8 aq[4];
#pragma unroll
        for (int ks = 0; ks < 4; ++ks) aq[ks] = ldfrag(sQ, rt * 16, ks, LQ, fr, fq);
#pragma unroll
        for (int c2 = 0; c2 < 2; ++c2) {
            const int ct = wh * 2 + c2;
            f32x4 pacc = (f32x4){0.f, 0.f, 0.f, 0.f};
#pragma unroll
            for (int ks = 0; ks < 4; ++ks) pacc = __builtin_amdgcn_mfma_f32_16x16x32_bf16(aq[ks], ldfrag(sK, ct * 16, ks, LQ, fr, fq), pacc, 0, 0, 0);
            const int jj = ct * 16 + fr; const float cj = scum[jj], ej = se[jj];
#pragma unroll
            for (int r = 0; r < 4; ++r) { const int ii = rt * 16 + fq * 4 + r;
                const float val = (jj <= ii) ? pacc[r] * __expf(crow[r] - cj) * ej : 0.f;
                sP[ii * LT + jj] = f2bf(val); }
        }
        f32x4 oacc[3];
#pragma unroll
        for (int v3 = 0; v3 < 3; ++v3) {
            const int vt = wh + 2 * v3;
            oacc[v3] = (f32x4){0.f, 0.f, 0.f, 0.f};
            if (vt < NVT) {
#pragma unroll
                for (int ks = 0; ks < 4; ++ks) oacc[v3] = __builtin_amdgcn_mfma_f32_16x16x32_bf16(aq[ks], ldfrag(sS, vt * 16, ks, LQ, fr, fq), oacc[v3], 0, 0, 0);
                oacc[v3] *= erow;
            }
        }
        __syncthreads();
        {
            bf16x8 ap[2];
#pragma unroll
            for (int ks = 0; ks < 2; ++ks) ap[ks] = ldfrag(sP, rt * 16, ks, LT, fr, fq);
#pragma unroll
            for (int v3 = 0; v3 < 3; ++v3) {
                const int vt = wh + 2 * v3;
                if (vt < NVT) {
#pragma unroll
                    for (int ks = 0; ks < 2; ++ks) oacc[v3] = __builtin_amdgcn_mfma_f32_16x16x32_bf16(ap[ks], ldfrag_tr(sV, ks * 32 + fq * 8, vt * 16, PV, fr), oacc[v3], 0, 0, 0);
                    const int vv = vt * 16 + fr;
#pragma unroll
                    for (int r = 0; r < 4; ++r) { const int ii = rt * 16 + fq * 4 + r;
                        if (vv < VW) sout[ii * VW + vv] = oacc[v3][r]; else if (vv == VW) sden[ii] = oacc[v3][r]; }
                }
            }
        }
        {
            const float sc = __expf(cend);
            bf16x8 ak[2];
#pragma unroll
            for (int ks = 0; ks < 2; ++ks) ak[ks] = ldfrag_tr(sK, ks * 32 + fq * 8, wid * 16, LQ, fr);
#pragma unroll
            for (int vt = 0; vt < NVT; ++vt) {
                Sacc[vt] *= sc;
#pragma unroll
                for (int ks = 0; ks < 2; ++ks) Sacc[vt] = __builtin_amdgcn_mfma_f32_16x16x32_bf16(ak[ks], ldfrag_tr(sVw, ks * 32 + fq * 8, vt * 16, PV, fr), Sacc[vt], 0, 0, 0);
                u32x2 w2; w2.x = pack2(Sacc[vt][0], Sacc[vt][1]); w2.y = pack2(Sacc[vt][2], Sacc[vt][3]);
                *(u32x2*)(sS + (vt * 16 + fr) * LQ + wid * 16 + fq * 4) = w2;
            }
        }
        __syncthreads();
        { const int i = tid_ >> 3, c8 = (tid_ & 7) * 8, pi = c0 + i, t = d ? (len - 1 - pi) : pi; float o[8]; ldf8(sout + i * 64 + c8, o);
          if (IS_SSD) st8(yd + (size_t)(rowbase + t) * DM + 512 + h * 64 + c8, o);
          else if (VW == 64) { st8(yd + (size_t)(rowbase + t) * DM + 1024 + h * 256 + vq * 64 + c8, o);
                 if (vq == 0 && tid_ < 64) { const int pj = c0 + tid_, tj = d ? (len - 1 - pj) : pj; den[(size_t)(rowbase + tj) * 4 + h] = sden[tid_]; } }
          else { if (tid_ < 256) { const int i2 = tid_ >> 2, c82 = (tid_ & 3) * 8, pi2 = c0 + i2, t2 = d ? (len - 1 - pi2) : pi2; float o2[8]; ldf8(sout + i2 * 32 + c82, o2);
                     st8(yd + (size_t)(rowbase + t2) * DM + 1024 + h * 256 + vq * 32 + c82, o2); }
                 if (vq == 0 && tid_ < 64) { const int pj = c0 + tid_, tj = d ? (len - 1 - pj) : pj; den[(size_t)(rowbase + tj) * 4 + h] = sden[tid_]; } } }
    }
}

__device__ void gdn_qk_prepass(CP& p) {
    OPQ_IDS;
    const int lane = tid_ & 63, wid = tid_ >> 6;
    const bf16_t* proj = (const bf16_t*)(p.ws + WS_BIG); bf16_t* qk = (bf16_t*)(p.ws + WS_ACT);
    for (int row = bid_ * 8 + wid; row < MTOT; row += gridDim.x * 8) {
        int t, len;
        if (row < MLAT) { t = row & (SEQ - 1); len = SEQ; } else { t = (row - MLAT) & (CTXL - 1); len = CTXL; }
        const bf16_t* pr = proj + (size_t)row * NO_MAIN;
#pragma unroll
        for (int ps = 0; ps < 4; ++ps) { const int c = ps * 512 + lane * 8;
            float x0[8], xm[8], xp[8], w0[8], w1[8], w2[8], o[8];
            ld8(pr + c, x0);
            if (t > 0) ld8(pr - NO_MAIN + c, xm); else { for (int q = 0; q < 8; ++q) xm[q] = 0.f; }
            if (t < len - 1) ld8(pr + NO_MAIN + c, xp); else { for (int q = 0; q < 8; ++q) xp[q] = 0.f; }
            ldf8(p.in[31] + c, w0); ldf8(p.in[31] + 3072 + c, w1); ldf8(p.in[31] + 6144 + c, w2);
            float ss = 0.f;
#pragma unroll
            for (int q = 0; q < 8; ++q) { o[q] = siluf_(w0[q] * xm[q] + w1[q] * x0[q] + w2[q] * xp[q]); ss += o[q] * o[q]; }
            ss = red16(ss);
            const float rs = rsqrtf(ss + 1e-6f) * (ps < 2 ? 0.08838834764831845f : 1.f);
#pragma unroll
            for (int q = 0; q < 8; ++q) o[q] *= rs;
            st8(qk + (size_t)row * 2048 + c, o); }
    }
}
struct GdnRaw { u32x2 qk[8]; u32x2 v0, vm, vp; };
__device__ __forceinline__ void gdn_load(GdnRaw& r, const bf16_t* proj, const bf16_t* qkbuf, int rowbase, int len, int c0, int d, int h, int vqr, int tid_) {
    asm volatile("" : "+v"(tid_));
#pragma unroll
    for (int k = 0; k < 8; ++k) { const int it = tid_ + k * NTHR, i = it >> 6, ch = (it & 63) * 4, pi = c0 + i, t = d ? (len - 1 - pi) : pi;
        r.qk[k] = *(const u32x2*)(qkbuf + (size_t)(rowbase + t) * 2048 + (ch < 128 ? (h * 128 + ch) : (1024 + h * 128 + (ch - 128)))); }
    { const int i = tid_ >> 3, ch = (tid_ & 7) * 4, pi = c0 + i, t = d ? (len - 1 - pi) : pi;
      const bf16_t* pp = proj + (size_t)(rowbase + t) * NO_MAIN + 2048 + h * 128 + vqr * 32 + ch;
      r.v0 = *(const u32x2*)pp; r.vm = *(const u32x2*)(pp - (t > 0 ? NO_MAIN : 0)); r.vp = *(const u32x2*)(pp + (t < len - 1 ? NO_MAIN : 0)); }
}
__device__ void scan_gdn256(CP& p, unsigned char* shm, int id) {
    OPQ_IDS;
    const int tid = tid_, lane = tid & 63, wid = tid >> 6;
    const int b = id >> 6, rem = id & 63, h = rem >> 3, d = (rem >> 2) & 1, vqr = rem & 3;
    constexpr int NCH = 288, RS = 292;
    float* srow = (float*)shm;
    float* scw = srow + 64 * RS;
    float* scb = scw + 3 * NCH;
    float* sout = scb + NCH;
    const bf16_t* proj = (const bf16_t*)(p.ws + WS_BIG);
    const float* gates = (const float*)(p.ws + WS_GATES);
    bf16_t* yd = (bf16_t*)(p.ws + WS_BIG + BIG_PROJ) + (size_t)d * MTOT * DM;
    auto colmap = [=](int ch) { return ch < 128 ? (h * 128 + ch) : (ch < 256 ? (1024 + h * 128 + (ch - 128)) : (2048 + h * 128 + vqr * 32 + (ch - 256))); };
    for (int e = tid; e < NCH; e += NTHR) { const int cc = colmap(e);
        scw[e] = p.in[31][cc]; scw[NCH + e] = p.in[31][3072 + cc]; scw[2 * NCH + e] = p.in[31][2 * 3072 + cc]; scb[e] = 0.f; }
    const float dtb = p.in[32][d * 8 + h], aexp = -expf(p.in[33][d * 8 + h]);
    const int ks = tid & 15, col = tid >> 4;
    f32x2 S2[4];
#pragma unroll
    for (int jx = 0; jx < 4; ++jx) S2[jx] = (f32x2){0.f, 0.f};
    __syncthreads();
    GdnRaw raw; float graw0 = 0.f, graw1 = 0.f;
    const bf16_t* qkbuf = (const bf16_t*)(p.ws + WS_ACT);
    { int len, rowbase, c0; chunk_pos(0, b, len, rowbase, c0); gdn_load(raw, proj, qkbuf, rowbase, len, c0, d, h, vqr, tid_);
      if (tid_ < 64) { const int pi = c0 + tid_, t = d ? (len - 1 - pi) : pi; const float* gp = gates + (size_t)(rowbase + t) * 64; graw0 = gp[d * 8 + h]; graw1 = gp[16 + d * 8 + h]; } }
    for (int cidx = 0; cidx < 68; ++cidx) {
        int len, rowbase, c0; chunk_pos(cidx, b, len, rowbase, c0);
        {
            int tl = tid_; asm volatile("" : "+v"(tl));
#pragma unroll
            for (int k = 0; k < 8; ++k) { const int it = tl + k * NTHR, i = it >> 6, ch = (it & 63) * 4; const u32x2 x = raw.qk[k];
                *(f32x4*)(srow + i * RS + ch) = (f32x4){lo16(x.x), hi16(x.x), lo16(x.y), hi16(x.y)}; }
            { const int i = tl >> 3, ch = 256 + (tl & 7) * 4, pi = c0 + i, t = d ? (len - 1 - pi) : pi;
              const u32x2 x0 = raw.v0, xm = raw.vm, xp = raw.vp;
              const f32x4 f0 = (f32x4){lo16(x0.x), hi16(x0.x), lo16(x0.y), hi16(x0.y)};
              const f32x4 fm = (t > 0) ? (f32x4){lo16(xm.x), hi16(xm.x), lo16(xm.y), hi16(xm.y)} : (f32x4){0.f, 0.f, 0.f, 0.f};
              const f32x4 fp = (t < len - 1) ? (f32x4){lo16(xp.x), hi16(xp.x), lo16(xp.y), hi16(xp.y)} : (f32x4){0.f, 0.f, 0.f, 0.f};
              f32x4 v = *(const f32x4*)(scw + ch) * fm + *(const f32x4*)(scw + NCH + ch) * f0 + *(const f32x4*)(scw + 2 * NCH + ch) * fp;
              v[0] = siluf_(v[0]); v[1] = siluf_(v[1]); v[2] = siluf_(v[2]); v[3] = siluf_(v[3]);
              *(f32x4*)(srow + i * RS + ch) = v; }
        }
        if (tid_ < 64) { srow[tid_ * RS + 288] = expf(aexp * softplusf_(graw1 + dtb)); srow[tid_ * RS + 289] = sigmoidf_(graw0); }
        __syncthreads();
        if (cidx + 1 < 68) { int len2, rowbase2, c02; chunk_pos(cidx + 1, b, len2, rowbase2, c02); gdn_load(raw, proj, qkbuf, rowbase2, len2, c02, d, h, vqr, tid_);
            if (tid_ < 64) { const int pi = c02 + tid_, t = d ? (len2 - 1 - pi) : pi; const float* gp = gates + (size_t)(rowbase2 + t) * 64; graw0 = gp[d * 8 + h]; graw1 = gp[16 + d * 8 + h]; } }
        {
            float* r0 = srow + (2 * (wid * 4 + (lane >> 4))) * RS; const float* r1 = r0 + RS; const int o8 = (lane & 15) * 8;
            const f32x4 k0a = *(const f32x4*)(r0 + 128 + o8), k0b = *(const f32x4*)(r0 + 132 + o8), k1a = *(const f32x4*)(r1 + 128 + o8), k1b = *(const f32x4*)(r1 + 132 + o8), q0a = *(const f32x4*)(r0 + o8), q0b = *(const f32x4*)(r0 + 4 + o8);
            float gk = k1a[0] * k0a[0] + k1a[1] * k0a[1] + k1a[2] * k0a[2] + k1a[3] * k0a[3] + k1b[0] * k0b[0] + k1b[1] * k0b[1] + k1b[2] * k0b[2] + k1b[3] * k0b[3];
            float rq2 = q0a[0] * k0a[0] + q0a[1] * k0a[1] + q0a[2] * k0a[2] + q0a[3] * k0a[3] + q0b[0] * k0b[0] + q0b[1] * k0b[1] + q0b[2] * k0b[2] + q0b[3] * k0b[3];
            gk = red16(gk); rq2 = red16(rq2);
            if ((lane & 15) == 0) { r0[290] = gk; r0[291] = rq2; }
        }
        __syncthreads();
        {
            const float* rk_p = srow + ks * 8;
            const float* rv_p = srow + 256 + col;
            float* so_p = sout + col;
            for (int m = 0; m < 32; ++m) {
                const f32x4 q0a = *(const f32x4*)(rk_p), q0b = *(const f32x4*)(rk_p + 4), k0a = *(const f32x4*)(rk_p + 128), k0b = *(const f32x4*)(rk_p + 132);
                const f32x4 q1a = *(const f32x4*)(rk_p + RS), q1b = *(const f32x4*)(rk_p + RS + 4), k1a = *(const f32x4*)(rk_p + RS + 128), k1b = *(const f32x4*)(rk_p + RS + 132);
                const f32x4 t0 = *(const f32x4*)(srow + (2 * m) * RS + 288);
                const float2 t1 = *(const float2*)(srow + (2 * m + 1) * RS + 288);
                const float v0 = rv_p[0], v1 = rv_p[RS];
                const f32x2 k0[4] = {{k0a[0], k0a[1]}, {k0a[2], k0a[3]}, {k0b[0], k0b[1]}, {k0b[2], k0b[3]}};
                const f32x2 k1[4] = {{k1a[0], k1a[1]}, {k1a[2], k1a[3]}, {k1b[0], k1b[1]}, {k1b[2], k1b[3]}};
                const f32x2 q0[4] = {{q0a[0], q0a[1]}, {q0a[2], q0a[3]}, {q0b[0], q0b[1]}, {q0b[2], q0b[3]}};
                const f32x2 q1[4] = {{q1a[0], q1a[1]}, {q1a[2], q1a[3]}, {q1b[0], q1b[1]}, {q1b[2], q1b[3]}};
                f32x2 d2 = k0[0] * S2[0], e2 = k1[0] * S2[0], f2 = q0[0] * S2[0];
#pragma unroll
                for (int e = 1; e < 4; ++e) { d2 = k0[e] * S2[e] + d2; e2 = k1[e] * S2[e] + e2; f2 = q0[e] * S2[e] + f2; }
                float dd = d2[0] + d2[1], ee = e2[0] + e2[1], ff = f2[0] + f2[1];
                dd += dppmov<0xB1>(dd); ee += dppmov<0xB1>(ee); ff += dppmov<0xB1>(ff);
                dd += dppmov<0x4E>(dd); ee += dppmov<0x4E>(ee); ff += dppmov<0x4E>(ff);
                dd += dppmov<0x141>(dd); ee += dppmov<0x141>(ee); ff += dppmov<0x141>(ff);
                dd += dppmov<0x140>(dd); ee += dppmov<0x140>(ee); ff += dppmov<0x140>(ff);
                const float w0 = t0[1] * (v0 - t0[0] * dd);
                const float o0 = t0[0] * ff + t0[3] * w0;
                const float d1 = t0[0] * ee + t0[2] * w0;
                const float w1 = t1.y * (v1 - t1.x * d1);
                const float c0s = t1.x * t0[0], c1s = t1.x * w0;
#pragma unroll
                for (int e = 0; e < 4; ++e) S2[e] = S2[e] * c0s + k0[e] * c1s + k1[e] * w1;
                f32x2 o2 = q1[0] * S2[0];
#pragma unroll
                for (int e = 1; e < 4; ++e) o2 = q1[e] * S2[e] + o2;
                const float o1 = red16(o2[0] + o2[1]);
                if (ks == 0) { so_p[(2 * m) * 32] = o0; so_p[(2 * m + 1) * 32] = o1; }
                rk_p += 2 * RS; rv_p += 2 * RS;
            }
        }
        __syncthreads();
        if (tid_ < 256) { const int i = tid_ >> 2, c8 = (tid_ & 3) * 8, pi = c0 + i, t = d ? (len - 1 - pi) : pi; float o[8]; ldf8(sout + i * 32 + c8, o);
            st8(yd + (size_t)(rowbase + t) * DM + h * 128 + vqr * 32 + c8, o); }
    }
}

__device__ void scan_s5v2(CP& p, unsigned char* shm, int s) {
    OPQ_IDS;
    const int lane = tid_ & 63, wid = tid_ >> 6, fr = lane & 15, fq = lane >> 4;
    const int b = s >> 6, rem = s & 63, g = rem >> 1, d = rem & 1, dg = d * 32 + g;
    constexpr int LU = 40;
    bf16_t* sU = (bf16_t*)shm;
    bf16_t* sBb = sU + 64 * LU;
    bf16_t* sX = sBb + 128 * LU;
    bf16_t* sCm = sX + 64 * LQ;
    float* sBU = (float*)(sCm + 16 * LQ);
    const bf16_t* proj = (const bf16_t*)(p.ws + WS_BIG);
    bf16_t* yd = (bf16_t*)(p.ws + WS_BIG + BIG_PROJ) + (size_t)d * MTOT * DM;
    float lbr = 0.f, lis = 0.f;
    if (tid_ < 128) {
        const int j = tid_, st = j >> 1, part = j & 1;
        const float lr = p.in[14][dg * 64 + st], li = p.in[15][dg * 64 + st], step = expf(p.in[16][dg]);
        const float ea = lr * step, eb = li * step, mag = expf(ea), cb = cosf(eb), sb = sinf(eb), shb = sinf(0.5f * eb);
        lbr = mag * cb; const float lbi = mag * sb;
        const float nr = expm1f(ea) * cb - 2.f * shb * shb, ni = lbi;
        const float den = lr * lr + li * li;
        const float qr = (nr * lr + ni * li) / den, qi = (ni * lr - nr * li) / den;
        lis = part ? lbi : -lbi;
#pragma unroll
        for (int hh = 0; hh < 16; ++hh) { const float br = p.in[17][(size_t)(dg * 64 + st) * 16 + hh], bi = p.in[18][(size_t)(dg * 64 + st) * 16 + hh];
            const float v = part ? (qr * bi + qi * br) : (qr * br - qi * bi);
            const bf16_t hi = f2bf(v); const bf16_t lo = f2bf(v - bf2f(hi));
            sBb[j * LU + hh] = hi; sBb[j * LU + 16 + hh] = lo;
            sCm[hh * LQ + j] = f2bf(part ? -p.in[20][(size_t)(dg * 16 + hh) * 64 + st] : p.in[19][(size_t)(dg * 16 + hh) * 64 + st]); }
    }
    float x = 0.f;
    u32x2 uraw = (u32x2){0u, 0u};
    if (tid_ < 256) { int len, rowbase, c0; chunk_pos(0, b, len, rowbase, c0); const int i = tid_ >> 2, hq = tid_ & 3, pi = c0 + i, t = d ? (len - 1 - pi) : pi;
        uraw = *(const u32x2*)(proj + (size_t)(rowbase + t) * NE_MAIN + g * 16 + hq * 4); }
    __syncthreads();
    for (int cidx = 0; cidx < 68; ++cidx) {
        int len, rowbase, c0; chunk_pos(cidx, b, len, rowbase, c0);
        if (tid_ < 256) { const int i = tid_ >> 2, hq = tid_ & 3; *(u32x2*)(sU + i * LU + hq * 4) = uraw; *(u32x2*)(sU + i * LU + 16 + hq * 4) = uraw; }
        __syncthreads();
#pragma unroll
        for (int q = 0; q < 4; ++q) { const int tile = wid * 4 + q, tt = tile >> 3, jt = tile & 7;
            f32x4 acc = (f32x4){0.f, 0.f, 0.f, 0.f};
            acc = __builtin_amdgcn_mfma_f32_16x16x32_bf16(ldfrag(sU, tt * 16, 0, LU, fr, fq), ldfrag(sBb, jt * 16, 0, LU, fr, fq), acc, 0, 0, 0);
#pragma unroll
            for (int r = 0; r < 4; ++r) sBU[(tt * 16 + fq * 4 + r) * 128 + jt * 16 + fr] = acc[r]; }
        __syncthreads();
        if (cidx + 1 < 68 && tid_ < 256) { int len2, rowbase2, c02; chunk_pos(cidx + 1, b, len2, rowbase2, c02); const int i = tid_ >> 2, hq = tid_ & 3, pi = c02 + i, t = d ? (len2 - 1 - pi) : pi;
            uraw = *(const u32x2*)(proj + (size_t)(rowbase2 + t) * NE_MAIN + g * 16 + hq * 4); }
        if (tid_ < 128) {
            float bun = sBU[tid_];
            for (int i = 0; i < 64; ++i) {
                const float bu = bun; if (i < 63) bun = sBU[(i + 1) * 128 + tid_];
                const float xp = dppmov<0xB1>(x);
                x = lbr * x + lis * xp + bu;
                sX[i * LQ + tid_] = f2bf(x);
            }
        }
        __syncthreads();
        if (wid < 4) {
            f32x4 acc = (f32x4){0.f, 0.f, 0.f, 0.f};
#pragma unroll
            for (int ks = 0; ks < 4; ++ks) acc = __builtin_amdgcn_mfma_f32_16x16x32_bf16(ldfrag(sX, wid * 16, ks, LQ, fr, fq), ldfrag(sCm, 0, ks, LQ, fr, fq), acc, 0, 0, 0);
#pragma unroll
            for (int r = 0; r < 4; ++r) { const int pi = c0 + wid * 16 + fq * 4 + r, t = d ? (len - 1 - pi) : pi;
                yd[(size_t)(rowbase + t) * DM + g * 16 + fr] = f2bf(acc[r]); }
        }
    }
}

__device__ void scan_s5v3(CP& p, unsigned char* shm, int id2) {
    OPQ_IDS;
    const int lane = tid_ & 63, wid = tid_ >> 6, fr = lane & 15, fq = lane >> 4;
    const int sl = wid >> 1, wp = wid & 1, j = tid_ & 127, st = j >> 1, part = j & 1;
    const int s = id2 * 4 + sl, b = s >> 6, rem = s & 63, g = rem >> 1, d = rem & 1, dg = d * 32 + g;
    constexpr int LU = 40, SCAN_BYTES = 2560 + 8704 + 16384;
    unsigned char* sb = shm + sl * SCAN_BYTES;
    bf16_t* sU = (bf16_t*)sb;
    bf16_t* sX = (bf16_t*)(sb + 2560);
    float* sBU = (float*)(sb + 2560 + 8704);
    const bf16_t* proj = (const bf16_t*)(p.ws + WS_BIG);
    bf16_t* yd = (bf16_t*)(p.ws + WS_BIG + BIG_PROJ) + (size_t)d * MTOT * DM;
    float lbr, lis;
    bf16x8 bfrag[4], cfrag[4];
    {
        bf16_t* tBb = (bf16_t*)shm + sl * (128 * LU);
        bf16_t* tCm = (bf16_t*)shm + 4 * (128 * LU) + sl * (16 * LQ);
        const float lr = p.in[14][dg * 64 + st], li = p.in[15][dg * 64 + st], step = expf(p.in[16][dg]);
        const float ea = lr * step, eb = li * step, mag = expf(ea), cb = cosf(eb), sbn = sinf(eb), shb = sinf(0.5f * eb);
        lbr = mag * cb; const float lbi = mag * sbn;
        const float nr = expm1f(ea) * cb - 2.f * shb * shb, ni = lbi;
        const float den = lr * lr + li * li;
        const float qr = (nr * lr + ni * li) / den, qi = (ni * lr - nr * li) / den;
        lis = part ? lbi : -lbi;
#pragma unroll
        for (int hh = 0; hh < 16; ++hh) { const float br = p.in[17][(size_t)(dg * 64 + st) * 16 + hh], bi = p.in[18][(size_t)(dg * 64 + st) * 16 + hh];
            const float v = part ? (qr * bi + qi * br) : (qr * br - qi * bi);
            const bf16_t hi = f2bf(v); const bf16_t lo = f2bf(v - bf2f(hi));
            tBb[j * LU + hh] = hi; tBb[j * LU + 16 + hh] = lo;
            tCm[hh * LQ + j] = f2bf(part ? -p.in[20][(size_t)(dg * 16 + hh) * 64 + st] : p.in[19][(size_t)(dg * 16 + hh) * 64 + st]); }
        __syncthreads();
#pragma unroll
        for (int q = 0; q < 4; ++q) { bfrag[q] = ldfrag(tBb, (wp * 4 + q) * 16, 0, LU, fr, fq); cfrag[q] = ldfrag(tCm, 0, q, LQ, fr, fq); }
        __syncthreads();
    }
    float x = 0.f;
    u32x2 uraw;
    { const int i = j >> 2, hq = j & 3, t = d ? (CTXL - 1 - i) : i;
      uraw = *(const u32x2*)(proj + (size_t)(MLAT + b * CTXL + t) * NE_MAIN + g * 16 + hq * 4); }
    for (int cidx = 0; cidx < 136; ++cidx) {
        int len, rowbase, c0;
        if (cidx < 8) { len = CTXL; rowbase = MLAT + b * CTXL; c0 = cidx * 32; } else { len = SEQ; rowbase = b * SEQ; c0 = (cidx - 8) * 32; }
        { const int i = j >> 2, hq = j & 3; *(u32x2*)(sU + i * LU + hq * 4) = uraw; *(u32x2*)(sU + i * LU + 16 + hq * 4) = uraw; }
        __syncthreads();
#pragma unroll
        for (int tt = 0; tt < 2; ++tt) { const bf16x8 au = ldfrag(sU, tt * 16, 0, LU, fr, fq);
#pragma unroll
            for (int q = 0; q < 4; ++q) { f32x4 acc = (f32x4){0.f, 0.f, 0.f, 0.f};
                acc = __builtin_amdgcn_mfma_f32_16x16x32_bf16(au, bfrag[q], acc, 0, 0, 0);
#pragma unroll
                for (int r = 0; r < 4; ++r) sBU[(tt * 16 + fq * 4 + r) * 128 + (wp * 4 + q) * 16 + fr] = acc[r]; } }
        __syncthreads();
        if (cidx + 1 < 136) { const int cn = cidx + 1; int len2, rowbase2, c02;
            if (cn < 8) { len2 = CTXL; rowbase2 = MLAT + b * CTXL; c02 = cn * 32; } else { len2 = SEQ; rowbase2 = b * SEQ; c02 = (cn - 8) * 32; }
            const int i = j >> 2, hq = j & 3, pi = c02 + i, t = d ? (len2 - 1 - pi) : pi;
            uraw = *(const u32x2*)(proj + (size_t)(rowbase2 + t) * NE_MAIN + g * 16 + hq * 4); }
        {
            float bun = sBU[j];
            for (int i = 0; i < 32; ++i) {
                const float bu = bun; if (i < 31) bun = sBU[(i + 1) * 128 + j];
                const float xp = dppmov<0xB1>(x);
                x = lbr * x + lis * xp + bu;
                sX[i * LQ + j] = f2bf(x);
            }
        }
        __syncthreads();
        {
            f32x4 acc = (f32x4){0.f, 0.f, 0.f, 0.f};
#pragma unroll
            for (int ks = 0; ks < 4; ++ks) acc = __builtin_amdgcn_mfma_f32_16x16x32_bf16(ldfrag(sX, wp * 16, ks, LQ, fr, fq), cfrag[ks], acc, 0, 0, 0);
#pragma unroll
            for (int r = 0; r < 4; ++r) { const int pi = c0 + wp * 16 + fq * 4 + r, t = d ? (len - 1 - pi) : pi;
                yd[(size_t)(rowbase + t) * DM + g * 16 + fr] = f2bf(acc[r]); }
        }
    }
}

__device__ void phase_post_even(CP& p) {
    OPQ_IDS;
    const int lane = tid_ & 63, wid = tid_ >> 6;
    const bf16_t* proj = (const bf16_t*)(p.ws + WS_BIG);
    const bf16_t* yd0 = (const bf16_t*)(p.ws + WS_BIG + BIG_PROJ); const bf16_t* yd1 = yd0 + (size_t)MTOT * DM;
    bf16_t* ybuf = (bf16_t*)(p.ws + WS_YBUF); bf16_t* ys5 = (bf16_t*)(p.ws + WS_YS5);
    for (int row = bid_ * 8 + wid; row < MTOT; row += gridDim.x * 8) {
        int t, len;
        if (row < MLAT) { t = row & (SEQ - 1); len = SEQ; } else { t = (row - MLAT) & (CTXL - 1); len = CTXL; }
        const bf16_t* pr = proj + (size_t)row * NE_MAIN;
        {
            const int c = lane * 8; float u[8], a[8], bq[8], dd[8], o[8];
            ld8(pr + c, u); ld8(yd0 + (size_t)row * DM + c, a); ld8(yd1 + (size_t)row * DM + c, bq); ldf8(p.in[21] + c, dd);
#pragma unroll
            for (int q = 0; q < 8; ++q) o[q] = gelu_tanh(dd[q] * u[q] + a[q] + bq[q]);
            st8(ys5 + (size_t)row * 512 + c, o);
        }
        for (int grp = 0; grp < 4; ++grp) {
            const bool act = lane < 48; const int ch = grp * 384 + (act ? lane : 0) * 8;
            float o[8]; float ss = 0.f;
            if (act) {
                float xm[8], x0[8], xp[8], a[8], bq[8], z[8], w0[8], w1[8], w2[8], cbv[8];
                ld8(pr + 2048 + ch, x0);
                if (t > 0) ld8(pr - NE_MAIN + 2048 + ch, xm); else { for (int q = 0; q < 8; ++q) xm[q] = 0.f; }
                if (t < len - 1) ld8(pr + NE_MAIN + 2048 + ch, xp); else { for (int q = 0; q < 8; ++q) xp[q] = 0.f; }
                ldf8(p.in[23] + ch, w0); ldf8(p.in[23] + 2560 + ch, w1); ldf8(p.in[23] + 5120 + ch, w2); ldf8(p.in[24] + ch, cbv);
                ld8(yd0 + (size_t)row * DM + 512 + ch, a); ld8(yd1 + (size_t)row * DM + 512 + ch, bq); ld8(pr + 512 + ch, z);
                const float dsk = p.in[27][ch >> 6];
#pragma unroll
                for (int q = 0; q < 8; ++q) { const float xs = siluf_(cbv[q] + w0[q] * xm[q] + w1[q] * x0[q] + w2[q] * xp[q]);
                    const float y = (a[q] + bq[q] + dsk * xs) * siluf_(z[q]); o[q] = y; ss += y * y; }
            }
            ss = red64(ss);
            const float rs = rsqrtf(ss * (1.f / 384.f) + 1e-6f);
            if (act) { float nwv[8]; ldf8(p.in[28] + ch, nwv);
#pragma unroll
                for (int q = 0; q < 8; ++q) o[q] = o[q] * rs * nwv[q];
                st8(ybuf + (size_t)row * DM + 512 + ch, o); }
        }
    }
}

__device__ void phase_post_odd(CP& p) {
    OPQ_IDS;
    const int lane = tid_ & 63, wid = tid_ >> 6;
    const bf16_t* proj = (const bf16_t*)(p.ws + WS_BIG);
    const bf16_t* yd0 = (const bf16_t*)(p.ws + WS_BIG + BIG_PROJ); const bf16_t* yd1 = yd0 + (size_t)MTOT * DM;
    const float* den0 = (const float*)(p.ws + WS_DEN); const float* den1 = den0 + (size_t)MTOT * 4;
    bf16_t* ybuf = (bf16_t*)(p.ws + WS_YBUF);
    for (int row = bid_ * 8 + wid; row < MTOT; row += gridDim.x * 8) {
        const bf16_t* pr = proj + (size_t)row * NO_MAIN;
        for (int half = 0; half < 2; ++half) {
            const int c = half * 512 + lane * 8; float a[8], bq[8], z[8], nwv[8], o[8]; float ss = 0.f;
            ld8(yd0 + (size_t)row * DM + c, a); ld8(yd1 + (size_t)row * DM + c, bq); ld8(pr + 3072 + c, z); ldf8(p.in[34] + (c & 127), nwv);
#pragma unroll
            for (int q = 0; q < 8; ++q) { o[q] = a[q] + bq[q]; ss += o[q] * o[q]; }
            ss = red16(ss);
            const float rs = rsqrtf(ss * (1.f / 128.f) + 1e-6f);
#pragma unroll
            for (int q = 0; q < 8; ++q) o[q] = o[q] * rs * nwv[q] * siluf_(z[q]);
            st8(ybuf + (size_t)row * DM + c, o);
        }
        for (int half = 0; half < 2; ++half) {
            const int c = half * 512 + lane * 8, hd = c >> 8; float a[8], bq[8], om[8], nwv[8], o[8]; float ss = 0.f;
            ld8(yd0 + (size_t)row * DM + 1024 + c, a); ld8(yd1 + (size_t)row * DM + 1024 + c, bq); ld8(pr + 6144 + c, om); ldf8(p.in[37] + c, nwv);
            const float i0 = 1.f / fmaxf(fabsf(den0[(size_t)row * 4 + hd]), 1.f), i1 = 1.f / fmaxf(fabsf(den1[(size_t)row * 4 + hd]), 1.f);
#pragma unroll
            for (int q = 0; q < 8; ++q) { o[q] = a[q] * i0 + bq[q] * i1; ss += o[q] * o[q]; }
            ss = red32(ss);
            const float rs = rsqrtf(ss * (1.f / 256.f) + 1e-6f);
#pragma unroll
            for (int q = 0; q < 8; ++q) o[q] = o[q] * rs * nwv[q] * sigmoidf_(om[q]);
            st8(ybuf + (size_t)row * DM + 1024 + c, o);
        }
    }
}

#define XB_TMO      128
#define XB_XCNT(j)  (256  + 64 * (j))
#define XB_XSUB(j)  (1280 + 64 * (j))
#define XB_XGEN(j)  (2304 + 64 * (j))
#define XB_TOP      3328
#define XB_TOPGEN   3392
#define XCD_BAR_WORDS 3456
#define XB_SPIN_CAP (1u << 18)
__device__ __forceinline__ unsigned xb_ld(unsigned* p)              { return __hip_atomic_load(p, __ATOMIC_RELAXED, __HIP_MEMORY_SCOPE_AGENT); }
__device__ __forceinline__ unsigned xb_add(unsigned* p, unsigned v) { return __hip_atomic_fetch_add(p, v, __ATOMIC_RELAXED, __HIP_MEMORY_SCOPE_AGENT); }
__device__ __forceinline__ unsigned xb_xcc_id() { return (unsigned)__builtin_amdgcn_s_getreg((3 << 11) | 20) & 0xFu; }
#define XB_SPIN(cond, bar) do { unsigned _sp = 0; while (cond) { __builtin_amdgcn_s_sleep(1); \
    if ((++_sp & 255u) == 0u) { if (xb_ld(&(bar)[XB_TMO])) break; if (_sp > XB_SPIN_CAP) { atomicAdd(&(bar)[XB_TMO], 1u); break; } } } } while (0)
struct XcdBarrier { unsigned* bar; unsigned x; volatile LAS unsigned* st; };
__device__ __forceinline__ void xcd_barrier_complete(unsigned* bar, unsigned x, unsigned& nloc, unsigned& nx) {
    const unsigned G = gridDim.x * gridDim.y * gridDim.z;
    unsigned sum, cnt, mine, sp = 0u;
    for (;;) {
        sum = 0u; cnt = 0u; mine = 0u;
#pragma unroll
        for (unsigned j = 0; j < 16; ++j) { const unsigned c = xb_ld(&bar[XB_XCNT(j)]); sum += c; cnt += (c > 0u) ? 1u : 0u; mine = (j == x) ? c : mine; }
        if (sum == G) break;
        __builtin_amdgcn_s_sleep(1);
        if ((++sp & 255u) == 0u) { if (xb_ld(&bar[XB_TMO])) break; if (sp > XB_SPIN_CAP) { atomicAdd(&bar[XB_TMO], 1u); break; } }
    }
    nloc = mine > 0u ? mine : 1u; nx = cnt > 0u ? cnt : 1u;
}
__device__ __forceinline__ void xcd_barrier(const XcdBarrier& b) {
    asm volatile("s_waitcnt vmcnt(0)" ::: "memory");
    __syncthreads();
    if (threadIdx.x == 0) {
        unsigned* bar = b.bar;
        __builtin_amdgcn_s_waitcnt(0);
        unsigned nloc = b.st[0], nx = b.st[1];
        if (nloc == 0u) { xcd_barrier_complete(bar, b.x, nloc, nx); b.st[0] = nloc; b.st[1] = nx; }
        const unsigned old = xb_add(&bar[XB_XSUB(b.x)], 1u);
        const unsigned gen = old / nloc;
        if (old + 1u == (gen + 1u) * nloc) {
            __builtin_amdgcn_fence(__ATOMIC_RELEASE, "agent");
            asm volatile("s_waitcnt vmcnt(0)" ::: "memory");
            const unsigned og = xb_add(&bar[XB_TOP], 1u);
            const unsigned tg = og / nx;
            if (og + 1u == (tg + 1u) * nx) xb_add(&bar[XB_TOPGEN], 1u);
            else XB_SPIN(xb_ld(&bar[XB_TOPGEN]) == tg, bar);
            __builtin_amdgcn_fence(__ATOMIC_ACQUIRE, "agent");
            xb_add(&bar[XB_XGEN(b.x)], 1u);
            asm volatile("s_waitcnt vmcnt(0)" ::: "memory");
        } else {
            XB_SPIN(xb_ld(&bar[XB_XGEN(b.x)]) == gen, bar);
            __builtin_amdgcn_fence(__ATOMIC_ACQUIRE, "agent");
            asm volatile("s_waitcnt vmcnt(0)" ::: "memory");
        }
    }
    __syncthreads();
}

__global__ void __launch_bounds__(NTHR, 2) fwd_megakernel(Params p_unused) {
    extern __shared__ __attribute__((aligned(16))) unsigned char shm[];
    cg::grid_group grid = cg::this_grid();
    volatile LAS unsigned* xb_st = (volatile LAS unsigned*)((LAS unsigned char*)shm + (LDS_BYTES - 16));
    if (threadIdx.x == 0) { xb_st[0] = 0u; xb_st[1] = 0u; }
    {
        CP* kp0 = (CP*)__builtin_amdgcn_kernarg_segment_ptr();
        unsigned* bw = (unsigned*)(kp0->ws + WS_BARW);
        if (blockIdx.x == 0) for (int e = threadIdx.x; e < XCD_BAR_WORDS; e += NTHR) bw[e] = 0u;
    }
    __syncthreads();
    for (int ph = 0; ph < 23; ++ph) {
        CP* kp = (CP*)__builtin_amdgcn_kernarg_segment_ptr(); asm volatile("" : "+s"(kp));
        CP& p = *kp;
        int bidk = blockIdx.x; asm volatile("" : "+s"(bidk));
        unsigned char* ws = p.ws;
        float* xc = (float*)(ws + WS_XC);
        bf16_t* act = (bf16_t*)(ws + WS_ACT);
        bf16_t* ybuf = (bf16_t*)(ws + WS_YBUF);
        bf16_t* big = (bf16_t*)(ws + WS_BIG);
        float* gates = (float*)(ws + WS_GATES);
        const float* modf = (const float*)(ws + WS_MODF);
        if (ph == 0) phase_prologue(p, shm);
        else if (ph == 1) phase_modreduce(p);
        else if (ph == 22) phase_final_norm(p);
        else {
            const int layer = (ph - 2) / 10, sub = (ph - 2) % 10;
            const bool even = (layer == 0);
            const int mres = even ? MTOT : MLAT;
            if (sub == 4 && !even) continue;
            if (sub == 0) phase_norm(p, layer, 0, MTOT, even);
            else if (sub == 6) phase_norm(p, layer, 1, mres, false);
            else if (sub == 1 || sub == 7) {
                const bool up = (sub == 7);
                const int nmain = up ? UPN : (even ? NE_MAIN : NO_MAIN), N = up ? UPN : (even ? NE : NO);
                const size_t wo = up ? (even ? WS_WUP0 : WS_WUP1) : (even ? WS_WINE : WS_WINO);
                pg8::EpiOut E{big, nmain, nmain / 256, gates};
                run_gemm(shm, act, DM, (const bf16_t*)(ws + wo), up ? mres : MTOT, N, DM, E);
            }
            else if (sub == 2) {
                if (even) { ssd_bc_prepass(p);
                            { XcdBarrier xb2; xb2.bar = (unsigned*)(ws + WS_BARW); xb2.x = xb_xcc_id(); xb2.st = xb_st; xcd_barrier(xb2); }
                            if (bidk < 192) scan_la<4, true, 64>(p, shm, bidk); else if (bidk < 256) scan_s5v3(p, shm, bidk - 192); }
                else      { gdn_qk_prepass(p);
                            { XcdBarrier xb2; xb2.bar = (unsigned*)(ws + WS_BARW); xb2.x = xb_xcc_id(); xb2.st = xb_st; xcd_barrier(xb2); }
                            if (bidk < 256) scan_gdn256(p, shm, bidk); __syncthreads(); if (bidk < 256) scan_la<3, false, 32>(p, shm, bidk); }
            }
            else if (sub == 3) { if (even) phase_post_even(p); else phase_post_odd(p); }
            else if (sub == 4) { pg8::EpiGlu E{(const bf16_t*)(ws + WS_YS5), ybuf}; run_gemm(shm, (const bf16_t*)(ws + WS_YS5), 512, (const bf16_t*)(ws + WS_WGLU), MTOT, 512, 512, E); }
            else if (sub == 5 || sub == 9) {
                const bool dn = (sub == 9);
                const bool first = even && !dn;
                pg8::EpiResid E{first ? p.in[0] : p.out, first ? p.in[2] : xc, p.out, xc, modf + (size_t)layer * 5 * MODN + (dn ? 5 : 2) * DM};
                const size_t wo = dn ? (even ? WS_WDN0 : WS_WDN1) : (even ? WS_WOUT0 : WS_WOUT1);
                run_gemm(shm, dn ? big + FFN : ybuf, dn ? UPN : DM, (const bf16_t*)(ws + wo), mres, DM, dn ? FFN : DM, E);
            }
            else if (sub == 8) phase_ffnconv(p, layer, mres);
        }
        if (ph == 0) { grid.sync(); if (threadIdx.x == 0) (void)xb_add(&((unsigned*)(ws + WS_BARW))[XB_XCNT(xb_xcc_id())], 1u); }
        else if (ph < 22) { XcdBarrier xb; xb.bar = (unsigned*)(ws + WS_BARW); xb.x = xb_xcc_id(); xb.st = xb_st; xcd_barrier(xb); }
    }
}

extern "C" void kernel_launch(void* const* d_in, const int* in_sizes, int n_in, void* d_out, int out_size, void* d_ws, size_t ws_size, hipStream_t stream) {
    static int grid_blocks = 0;
    if (grid_blocks == 0) {
        if (n_in != 38 || out_size != MLAT * DM || ws_size < WS_END) { fprintf(stderr, "kernel_launch: unexpected shapes: n_in %d out %d ws %zu (need %zu)\n", n_in, out_size, ws_size, (size_t)WS_END); grid_blocks = -1; return; }
        int dev = 0, cus = 0, per_cu = 0;
        hipGetDevice(&dev);
        hipDeviceGetAttribute(&cus, hipDeviceAttributeMultiprocessorCount, dev);
        if (hipFuncSetAttribute((const void*)fwd_megakernel, hipFuncAttributeMaxDynamicSharedMemorySize, LDS_BYTES) != hipSuccess) { fprintf(stderr, "kernel_launch: hipFuncSetAttribute failed\n"); grid_blocks = -1; return; }
        hipOccupancyMaxActiveBlocksPerMultiprocessor(&per_cu, (const void*)fwd_megakernel, NTHR, LDS_BYTES);
        if (per_cu < 1) { fprintf(stderr, "kernel_launch: occupancy query says %d blocks/CU\n", per_cu); per_cu = 1; }
        (void)hipGetLastError();
        grid_blocks = cus;
        if (grid_blocks < 256) fprintf(stderr, "kernel_launch: only %d CUs; scans need 256 workgroups\n", grid_blocks);
        if (grid_blocks > 256) grid_blocks = 256;
    }
    if (grid_blocks < 0) return;
    Params p{};
    for (int i = 0; i < 38; ++i) p.in[i] = (const float*)d_in[i];
    p.out = (float*)d_out; p.ws = (unsigned char*)d_ws;
    void* args[] = {&p};
    hipError_t e = hipLaunchCooperativeKernel((const void*)fwd_megakernel, dim3(grid_blocks), dim3(NTHR), args, LDS_BYTES, stream);
    if (e != hipSuccess) fprintf(stderr, "cooperative launch failed: %s (grid %d)\n", hipGetErrorString(e), grid_blocks);
}
```

```cpp
#include <hip/hip_runtime.h>
#include <hip/hip_cooperative_groups.h>
#include <cstdio>
namespace cg = cooperative_groups;

#define LAS __attribute__((address_space(3)))
typedef unsigned short bf16_t;
typedef short bf16x8 __attribute__((ext_vector_type(8)));
typedef float f32x4 __attribute__((ext_vector_type(4)));
typedef unsigned u32x4 __attribute__((ext_vector_type(4)));
typedef unsigned u32x2 __attribute__((ext_vector_type(2)));
typedef float f32x2 __attribute__((ext_vector_type(2)));

constexpr int DM = 2048, NBATCH = 4, SEQ = 4096, CTXL = 256;
constexpr int MLAT = NBATCH * SEQ, MCTX = NBATCH * CTXL, MTOT = MLAT + MCTX;
constexpr int NE_MAIN = 4608, NE = 4864, NE_SRC = 4656;
constexpr int NO_MAIN = 7168, NO = 7424, NO_SRC = 7216;
constexpr int FFN = 5504, UPN = 11008;
constexpr int MODN = 6 * DM;
constexpr int NTHR = 512;
constexpr int LDS_BYTES = 136 * 1024;

constexpr size_t al256(size_t x) { return (x + 255) & ~size_t(255); }
constexpr size_t WS_WINE = 0;
constexpr size_t WS_WINO = WS_WINE + al256((size_t)NE * DM * 2);
constexpr size_t WS_WOUT0 = WS_WINO + al256((size_t)NO * DM * 2);
constexpr size_t WS_WOUT1 = WS_WOUT0 + al256((size_t)DM * DM * 2);
constexpr size_t WS_WUP0 = WS_WOUT1 + al256((size_t)DM * DM * 2);
constexpr size_t WS_WUP1 = WS_WUP0 + al256((size_t)UPN * DM * 2);
constexpr size_t WS_WDN0 = WS_WUP1 + al256((size_t)UPN * DM * 2);
constexpr size_t WS_WDN1 = WS_WDN0 + al256((size_t)DM * FFN * 2);
constexpr size_t WS_WGLU = WS_WDN1 + al256((size_t)DM * FFN * 2);
constexpr size_t WS_MODP = WS_WGLU + al256((size_t)512 * 512 * 2);
constexpr size_t WS_MODF = WS_MODP + al256((size_t)32 * 2 * 5 * MODN * 4);
constexpr size_t WS_XC = WS_MODF + al256((size_t)2 * 5 * MODN * 4);
constexpr size_t WS_ACT = WS_XC + al256((size_t)MCTX * DM * 4);
constexpr size_t WS_YBUF = WS_ACT + al256((size_t)MTOT * DM * 2);
constexpr size_t WS_GATES = WS_YBUF + al256((size_t)MTOT * DM * 2);
constexpr size_t WS_DEN = WS_GATES + al256((size_t)MTOT * 64 * 4);
constexpr size_t WS_YS5 = WS_DEN + al256((size_t)2 * MTOT * 4 * 4);
constexpr size_t WS_BIG = WS_YS5 + al256((size_t)MTOT * 512 * 2);
constexpr size_t BIG_PROJ = al256((size_t)MTOT * NO_MAIN * 2);
constexpr size_t BIG_A = BIG_PROJ + al256((size_t)2 * MTOT * DM * 2);
constexpr size_t BIG_B = al256((size_t)MTOT * UPN * 2);
constexpr size_t WS_BARW = WS_BIG + (BIG_A > BIG_B ? BIG_A : BIG_B);
constexpr size_t WS_END = WS_BARW + 16384;

struct Params { const float* in[38]; float* out; unsigned char* ws; };
typedef const __attribute__((address_space(4))) Params CP;
#define OPQ_IDS int tid_ = threadIdx.x; asm volatile("" : "+v"(tid_)); int bid_ = blockIdx.x; asm volatile("" : "+s"(bid_))

__device__ __forceinline__ float bf2f(bf16_t b) { return __uint_as_float(((unsigned)b) << 16); }
typedef __bf16 bf16x2_t __attribute__((ext_vector_type(2)));
__device__ __forceinline__ bf16_t f2bf(float f) { const __bf16 h = (__bf16)f; return __builtin_bit_cast(unsigned short, h); }
__device__ __forceinline__ unsigned pack2(float lo, float hi) { bf16x2_t v; v[0] = (__bf16)lo; v[1] = (__bf16)hi; return __builtin_bit_cast(unsigned, v); }
__device__ __forceinline__ float lo16(unsigned w) { return __uint_as_float(w << 16); }
__device__ __forceinline__ float hi16(unsigned w) { return __uint_as_float(w & 0xFFFF0000u); }
__device__ __forceinline__ float sigmoidf_(float x) { return __builtin_amdgcn_rcpf(1.f + __expf(-x)); }
__device__ __forceinline__ float siluf_(float x) { return x * __builtin_amdgcn_rcpf(1.f + __expf(-x)); }
__device__ __forceinline__ float softplusf_(float x) { return fmaxf(x, 0.f) + log1pf(expf(-fabsf(x))); }
__device__ __forceinline__ float gelu_tanh(float x) { const float u = 0.7978845608028654f * (x + 0.044715f * x * x * x); return 0.5f * x * (1.f + tanhf(u)); }
template <int CTRL> __device__ __forceinline__ float dppmov(float v) { return __int_as_float(__builtin_amdgcn_update_dpp(0, __float_as_int(v), CTRL, 0xF, 0xF, true)); }
__device__ __forceinline__ float red8(float v) { v += dppmov<0xB1>(v); v += dppmov<0x4E>(v); v += dppmov<0x141>(v); return v; }
__device__ __forceinline__ float red16(float v) { v = red8(v); v += dppmov<0x140>(v); return v; }
__device__ __forceinline__ float red32(float v) { v = red16(v); v += __shfl_xor(v, 16, 64); return v; }
__device__ __forceinline__ float red64(float v) { v = red16(v); v += __shfl_xor(v, 16, 64); v += __shfl_xor(v, 32, 64); return v; }

namespace pg8 {
constexpr int BM = 256, BK = 64, HALF = 128, HTB = HALF * BK * 2, STAGE_BYTES = 8 * HTB, NXCD = 8, WGM = 8;
__device__ __forceinline__ int lds_byte(int r, int c) { const int st = (r >> 4) * 2 + (c >> 5), rr = r & 15, cc = c & 31, ob = rr * 64 + cc * 2; return st * 1024 + (ob ^ (((ob >> 9) & 1) << 5)); }
__device__ __forceinline__ void stage_rc(int b, int& R, int& C) { const int st = b / 1024, sb = b % 1024, swz = sb ^ (((sb >> 9) & 1) << 5); R = (st >> 1) * 16 + swz / 64; C = (st & 1) * 32 + (swz % 64) / 2; }
__device__ __forceinline__ int perm32(int rho) { const int n = rho >> 4, i = rho & 15; return 8 * (i >> 2) + 4 * n + (i & 3); }
struct Unit { int pm, pn; };
struct Gemm { const bf16_t* A; const bf16_t* Bt; int M, N, K, lda; };
struct StaticOrder {
    int nM, nN, nwg, G, c;
    __device__ void init(int M, int N, int G_, int c_) { nM = M / BM; nN = N / BM; nwg = nM * nN; G = G_; c = c_; }
    __device__ bool next(int i, Unit& u) const {
        const long L = (long)i * G + c; if (L >= nwg) return false;
        int wgid = (int)L; { const int q = nwg / NXCD, r = nwg % NXCD, xcd = wgid % NXCD, off = wgid / NXCD; wgid = (xcd < r ? xcd * (q + 1) : r * (q + 1) + (xcd - r) * q) + off; }
        const int nig = WGM * nN, gid = wgid / nig, fm = gid * WGM, gsz = (nM - fm) < WGM ? (nM - fm) : WGM;
        u.pm = fm + ((wgid % nig) % gsz); u.pn = (wgid % nig) / gsz; return true;
    }
};
__device__ __forceinline__ unsigned cvt_pk_bf16(float lo, float hi) { unsigned r; asm volatile("v_cvt_pk_bf16_f32 %0, %1, %2" : "=v"(r) : "v"(lo), "v"(hi)); return r; }

template <class Epi>
__device__ __forceinline__ void gemm_phase(LAS unsigned char* lds, const Gemm g, const StaticOrder& S, const Epi& E) {
    int tid = threadIdx.x; asm volatile("" : "+v"(tid));
    const int wid = __builtin_amdgcn_readfirstlane(tid >> 6), lane = tid & 63, wr = wid >> 2, wc = wid & 3, fr = lane & 15, fq = lane >> 4;
    const int K = g.K, nt = K / BK, lda = g.lda;
    unsigned voffA[2], voffB[2];
#pragma unroll
    for (int i = 0; i < 2; ++i) { int R, C; stage_rc(tid * 16 + i * 8192, R, C); const int Rb = Epi::PERM ? ((R & ~31) + perm32(R & 31)) : R;
        voffA[i] = (unsigned)(R * lda + C) * 2u; voffB[i] = (unsigned)(Rb * K + C) * 2u; }
    const size_t kstep = (size_t)(BK * 2);
    const size_t hstepA = (size_t)HALF * lda * 2, hstepB = (size_t)HALF * K * 2;
    const size_t tstepA = 2 * hstepA, tstepB = 2 * hstepB;
    const unsigned ldsw = (unsigned)wid * 1024u;
    const int aoff = lds_byte(wr * 64 + fr, fq * 8), boff = lds_byte(wc * 32 + fr, fq * 8);
#define PG8_SA(b, h) (((b) * 2 + (h)) * HTB)
#define PG8_SB(b, h) ((4 + (b) * 2 + (h)) * HTB)
#define PG8_STAGE(bufoff, gbase, voff) do { _Pragma("unroll") for (int _i = 0; _i < 2; ++_i) \
        __builtin_amdgcn_global_load_lds((const unsigned*)((const char*)(gbase) + (voff)[_i]), (LAS unsigned*)(lds + (bufoff) + ldsw + _i * 8192), 16, 0, 0); } while (0)
#define PG8_LDA(dst, b, h) do { _Pragma("unroll") for (int m = 0; m < 4; ++m) _Pragma("unroll") for (int k = 0; k < 2; ++k) dst[m][k] = *(const LAS bf16x8*)(lds + PG8_SA(b, h) + aoff + m * 2048 + k * 1024); } while (0)
#define PG8_LDB(dst, b, h) do { _Pragma("unroll") for (int n = 0; n < 2; ++n) _Pragma("unroll") for (int k = 0; k < 2; ++k) dst[n][k] = *(const LAS bf16x8*)(lds + PG8_SB(b, h) + boff + n * 2048 + k * 1024); } while (0)
#define PG8_MMA(ai, bj, At, Bt) do { __builtin_amdgcn_s_setprio(1); _Pragma("unroll") for (int m = 0; m < 4; ++m) _Pragma("unroll") for (int n = 0; n < 2; ++n) _Pragma("unroll") for (int k = 0; k < 2; ++k) \
        acc[ai][bj][m][n] = __builtin_amdgcn_mfma_f32_16x16x32_bf16(Bt[n][k], At[m][k], acc[ai][bj][m][n], 0, 0, 0); __builtin_amdgcn_s_setprio(0); } while (0)
#define PG8_WAIT_V(n) asm volatile("s_waitcnt vmcnt(" #n ")" ::: "memory")
#define PG8_WAIT_L(n) asm volatile("s_waitcnt lgkmcnt(" #n ")" ::: "memory")
#define PG8_BAR __builtin_amdgcn_s_barrier()
#define PG8_SCHED __builtin_amdgcn_sched_barrier(0)
    Unit cur, nxt; int ui = 0;
    if (!S.next(0, cur)) return;
    f32x4 acc[2][2][4][2];
#pragma unroll
    for (int a = 0; a < 2; ++a)
#pragma unroll
        for (int b = 0; b < 2; ++b)
#pragma unroll
            for (int m = 0; m < 4; ++m)
#pragma unroll
                for (int n = 0; n < 2; ++n) acc[a][b][m][n] = (f32x4){0.f, 0.f, 0.f, 0.f};
    bf16x8 At[4][2], B0[2][2], B1[2][2];
    const char* cA = (const char*)g.A + (size_t)cur.pm * tstepA; const char* cB = (const char*)g.Bt + (size_t)cur.pn * tstepB;
    PG8_STAGE(PG8_SB(0, 0), cB, voffB); PG8_STAGE(PG8_SA(0, 0), cA, voffA); PG8_STAGE(PG8_SB(0, 1), cB + hstepB, voffB); PG8_STAGE(PG8_SA(0, 1), cA + hstepA, voffA);
    if (wr == 1) PG8_BAR;
    PG8_WAIT_V(4); PG8_BAR;
    PG8_STAGE(PG8_SB(1, 0), cB + kstep, voffB); PG8_STAGE(PG8_SA(1, 0), cA + kstep, voffA); PG8_STAGE(PG8_SB(1, 1), cB + hstepB + kstep, voffB);
    PG8_WAIT_V(6); PG8_BAR;
    for (;;) {
        const bool has_next = S.next(ui + 1, nxt);
        const char* nA = has_next ? (const char*)g.A + (size_t)nxt.pm * tstepA : cA; const char* nB = has_next ? (const char*)g.Bt + (size_t)nxt.pn * tstepB : cB;
        for (int t = 0; t < nt; t += 2) {
            const bool last = (t == nt - 2);
            const char* a1 = cA + (size_t)(t + 1) * kstep;
            const char* a2 = last ? nA : cA + (size_t)(t + 2) * kstep; const char* b2 = last ? nB : cB + (size_t)(t + 2) * kstep;
            const char* a3 = a2 + kstep; const char* b3 = b2 + kstep;
            PG8_LDB(B0, 0, 0); PG8_SCHED; PG8_LDA(At, 0, 0); PG8_STAGE(PG8_SA(1, 1), a1 + hstepA, voffA);
            PG8_WAIT_L(8); PG8_BAR; PG8_WAIT_L(0); PG8_MMA(0, 0, At, B0); PG8_BAR; PG8_SCHED;
            PG8_LDB(B1, 0, 1); PG8_STAGE(PG8_SB(0, 0), b2, voffB);
            PG8_BAR; PG8_WAIT_L(0); PG8_MMA(0, 1, At, B1); PG8_BAR;
            PG8_LDA(At, 0, 1); PG8_STAGE(PG8_SA(0, 0), a2, voffA);
            PG8_BAR; PG8_WAIT_L(0); PG8_MMA(1, 0, At, B0); PG8_BAR; PG8_SCHED;
            PG8_STAGE(PG8_SB(0, 1), b2 + hstepB, voffB);
            PG8_WAIT_V(6); PG8_BAR; PG8_MMA(1, 1, At, B1); PG8_BAR;
            PG8_LDB(B0, 1, 0); PG8_SCHED; PG8_LDA(At, 1, 0); PG8_STAGE(PG8_SA(0, 1), a2 + hstepA, voffA);
            PG8_WAIT_L(8); PG8_BAR; PG8_WAIT_L(0); PG8_MMA(0, 0, At, B0); PG8_BAR; PG8_SCHED;
            PG8_LDB(B1, 1, 1); PG8_STAGE(PG8_SB(1, 0), b3, voffB);
            PG8_BAR; PG8_WAIT_L(0); PG8_MMA(0, 1, At, B1); PG8_BAR;
            PG8_LDA(At, 1, 1); PG8_STAGE(PG8_SA(1, 0), a3, voffA);
            PG8_BAR; PG8_WAIT_L(0); PG8_MMA(1, 0, At, B0); PG8_BAR; PG8_SCHED;
            PG8_STAGE(PG8_SB(1, 1), b3 + hstepB, voffB);
            PG8_WAIT_V(6); PG8_BAR; PG8_MMA(1, 1, At, B1); PG8_BAR;
        }
        E(acc, cur, wr, wc, fr, fq);
        if (!has_next) break;
#pragma unroll
        for (int a = 0; a < 2; ++a)
#pragma unroll
            for (int b = 0; b < 2; ++b)
#pragma unroll
                for (int m = 0; m < 4; ++m)
#pragma unroll
                    for (int n = 0; n < 2; ++n) acc[a][b][m][n] = (f32x4){0.f, 0.f, 0.f, 0.f};
        cur = nxt; cA = nA; cB = nB; ++ui;
    }
    PG8_WAIT_V(0);
    if (wr == 0) PG8_BAR;
    PG8_BAR;
#undef PG8_SA
#undef PG8_SB
#undef PG8_STAGE
#undef PG8_LDA
#undef PG8_LDB
#undef PG8_MMA
#undef PG8_WAIT_V
#undef PG8_WAIT_L
#undef PG8_BAR
#undef PG8_SCHED
}

struct EpiOut {
    static constexpr bool PERM = true;
    bf16_t* O; int ldc; int n_main; float* G;
    __device__ __forceinline__ void operator()(const f32x4 (&acc)[2][2][4][2], const Unit& u, int wr, int wc, int fr, int fq) const {
        const int row0 = u.pm * BM + wr * 64 + fr;
        if (u.pn < n_main) {
            const int col0 = u.pn * BM + wc * 32 + 8 * fq;
#pragma unroll
            for (int ai = 0; ai < 2; ++ai)
#pragma unroll
                for (int m = 0; m < 4; ++m) { bf16_t* rowp = O + (size_t)(row0 + ai * HALF + m * 16) * ldc + col0;
#pragma unroll
                    for (int bj = 0; bj < 2; ++bj) { const f32x4 v0 = acc[ai][bj][m][0], v1 = acc[ai][bj][m][1];
                        u32x4 w; w.x = cvt_pk_bf16(v0[0], v0[1]); w.y = cvt_pk_bf16(v0[2], v0[3]); w.z = cvt_pk_bf16(v1[0], v1[1]); w.w = cvt_pk_bf16(v1[2], v1[3]);
                        *(u32x4*)(rowp + bj * HALF) = w; } }
        } else if (wc < 2) {
#pragma unroll
            for (int ai = 0; ai < 2; ++ai)
#pragma unroll
                for (int m = 0; m < 4; ++m) { float* rowp = G + (size_t)(row0 + ai * HALF + m * 16) * 64 + wc * 32 + 8 * fq;
                    *(f32x4*)(rowp) = acc[ai][0][m][0]; *(f32x4*)(rowp + 4) = acc[ai][0][m][1]; }
        }
    }
};
struct EpiResid {
    static constexpr bool PERM = false;
    const float* xin_lat; const float* xin_ctx; float* xout_lat; float* xout_ctx; const float* gate;
    __device__ __forceinline__ void operator()(const f32x4 (&acc)[2][2][4][2], const Unit& u, int wr, int wc, int fr, int fq) const {
        int rowt = u.pm * BM; const float* xi; float* xo; const float* gv;
        if (rowt < MLAT) { xi = xin_lat + (size_t)rowt * DM; xo = xout_lat + (size_t)rowt * DM; gv = gate + (size_t)(rowt >> 12) * MODN; }
        else { rowt -= MLAT; xi = xin_ctx + (size_t)rowt * DM; xo = xout_ctx + (size_t)rowt * DM; gv = gate + (size_t)4 * MODN; }
        const int lrow0 = wr * 64 + fr, col0 = u.pn * BM + wc * 32 + 4 * fq;
        f32x4 gvv[2][2];
#pragma unroll
        for (int bj = 0; bj < 2; ++bj)
#pragma unroll
            for (int n = 0; n < 2; ++n) gvv[bj][n] = *(const f32x4*)(gv + col0 + bj * HALF + n * 16);
#pragma unroll
        for (int ai = 0; ai < 2; ++ai)
#pragma unroll
            for (int m = 0; m < 4; ++m) { const size_t off = (size_t)(lrow0 + ai * HALF + m * 16) * DM + col0;
#pragma unroll
                for (int bj = 0; bj < 2; ++bj)
#pragma unroll
                    for (int n = 0; n < 2; ++n) { const f32x4 xv = *(const f32x4*)(xi + off + bj * HALF + n * 16);
                        *(f32x4*)(xo + off + bj * HALF + n * 16) = xv + gvv[bj][n] * acc[ai][bj][m][n]; } }
    }
};
struct EpiGlu {
    static constexpr bool PERM = true;
    const bf16_t* Y; bf16_t* O;
    __device__ __forceinline__ void operator()(const f32x4 (&acc)[2][2][4][2], const Unit& u, int wr, int wc, int fr, int fq) const {
        const int row0 = u.pm * BM + wr * 64 + fr, col0 = u.pn * BM + wc * 32 + 8 * fq;
#pragma unroll
        for (int ai = 0; ai < 2; ++ai)
#pragma unroll
            for (int m = 0; m < 4; ++m) { const int row = row0 + ai * HALF + m * 16;
#pragma unroll
                for (int bj = 0; bj < 2; ++bj) { const u32x4 yv = *(const u32x4*)(Y + (size_t)row * 512 + col0 + bj * HALF);
                    const f32x4 v0 = acc[ai][bj][m][0], v1 = acc[ai][bj][m][1];
                    u32x4 w;
                    w.x = cvt_pk_bf16(lo16(yv.x) * sigmoidf_(v0[0]), hi16(yv.x) * sigmoidf_(v0[1]));
                    w.y = cvt_pk_bf16(lo16(yv.y) * sigmoidf_(v0[2]), hi16(yv.y) * sigmoidf_(v0[3]));
                    w.z = cvt_pk_bf16(lo16(yv.z) * sigmoidf_(v1[0]), hi16(yv.z) * sigmoidf_(v1[1]));
                    w.w = cvt_pk_bf16(lo16(yv.w) * sigmoidf_(v1[2]), hi16(yv.w) * sigmoidf_(v1[3]));
                    *(u32x4*)(O + (size_t)row * DM + col0 + bj * HALF) = w; } }
    }
};
}

template <class Epi>
__device__ __forceinline__ void run_gemm(unsigned char* shm, const bf16_t* A, int lda, const bf16_t* Bt, int M, int N, int K, const Epi& E) {
    int bid_ = blockIdx.x; asm volatile("" : "+s"(bid_));
    pg8::Gemm g{A, Bt, M, N, K, lda}; pg8::StaticOrder S; S.init(M, N, (int)gridDim.x, bid_);
    pg8::gemm_phase<Epi>((LAS unsigned char*)shm, g, S, E);
}

__device__ __forceinline__ void ld8(const bf16_t* p, float (&v)[8]) { const u32x4 r = *(const u32x4*)p; v[0] = lo16(r.x); v[1] = hi16(r.x); v[2] = lo16(r.y); v[3] = hi16(r.y); v[4] = lo16(r.z); v[5] = hi16(r.z); v[6] = lo16(r.w); v[7] = hi16(r.w); }
__device__ __forceinline__ void st8(bf16_t* p, const float (&v)[8]) { u32x4 w; w.x = pack2(v[0], v[1]); w.y = pack2(v[2], v[3]); w.z = pack2(v[4], v[5]); w.w = pack2(v[6], v[7]); *(u32x4*)p = w; }
__device__ __forceinline__ void ldf8(const float* p, float (&v)[8]) { const f32x4 a = *(const f32x4*)p, b = *(const f32x4*)(p + 4); v[0] = a[0]; v[1] = a[1]; v[2] = a[2]; v[3] = a[3]; v[4] = b[0]; v[5] = b[1]; v[6] = b[2]; v[7] = b[3]; }


struct CvtDesc { const float* src; bf16_t* dst; int K, Nsrc, Ndst, mode; };
__device__ __forceinline__ int cvt_srccol(int mode, int n, int Nsrc) {
    if (mode == 0) return n < Nsrc ? n : -1;
    if (n < 4096) return n;
    if (n < 7168) return n + 32;
    if (n < 7200) return 4096 + (n - 7168);
    if (n < 7216) return n;
    return -1;
}
constexpr int CVT_T0 = 0;
constexpr int CVT_T1 = CVT_T0 + (NE / 256) * (DM / 64);
constexpr int CVT_T2 = CVT_T1 + (NO / 256) * (DM / 64);
constexpr int CVT_T3 = CVT_T2 + (DM / 256) * (DM / 64);
constexpr int CVT_T4 = CVT_T3 + (DM / 256) * (DM / 64);
constexpr int CVT_T5 = CVT_T4 + (UPN / 256) * (DM / 64);
constexpr int CVT_T6 = CVT_T5 + (UPN / 256) * (DM / 64);
constexpr int CVT_T7 = CVT_T6 + (DM / 256) * (FFN / 64);
constexpr int CVT_T8 = CVT_T7 + (DM / 256) * (FFN / 64);
constexpr int CVT_T9 = CVT_T8 + 2 * 8;
constexpr int N_MOD_ITEMS = 2 * 6 * 32;
constexpr int CVT_PITCH = 260;

__device__ void phase_prologue(CP& p, unsigned char* shm) {
    OPQ_IDS;
    const int tid = tid_;
    float* lds = (float*)shm;
    unsigned char* ws = p.ws;
    for (int item = bid_; item < N_MOD_ITEMS + CVT_T9; item += gridDim.x) {
        if (item < N_MOD_ITEMS) {
            const int layer = item / 192, rem = item % 192, cc = rem >> 5, kc = rem & 31;
            if (tid < 320) { const int r = tid >> 6, k = tid & 63; const float v = (r < 4) ? p.in[1][r * DM + kc * 64 + k] : p.in[3][kc * 64 + k]; lds[tid] = v / (1.f + expf(-v)); }
            __syncthreads();
            const int col = cc * 2048 + tid * 4;
            const float* w = p.in[4] + ((size_t)layer * DM + kc * 64) * MODN + col;
            f32x4 a0 = {0.f, 0.f, 0.f, 0.f}, a1 = a0, a2 = a0, a3 = a0, a4 = a0;
#pragma unroll 16
            for (int k = 0; k < 64; ++k) { const f32x4 wv = *(const f32x4*)(w + (size_t)k * MODN); a0 += wv * lds[k]; a1 += wv * lds[64 + k]; a2 += wv * lds[128 + k]; a3 += wv * lds[192 + k]; a4 += wv * lds[256 + k]; }
            float* mp = (float*)(ws + WS_MODP) + ((size_t)(kc * 2 + layer) * 5) * MODN + col;
            *(f32x4*)(mp) = a0; *(f32x4*)(mp + MODN) = a1; *(f32x4*)(mp + 2 * MODN) = a2; *(f32x4*)(mp + 3 * MODN) = a3; *(f32x4*)(mp + 4 * MODN) = a4;
            __syncthreads();
        } else {
            const int t = item - N_MOD_ITEMS;
            CvtDesc c; int tl;
            if (t < CVT_T1)      { c = CvtDesc{p.in[12], (bf16_t*)(ws + WS_WINE), DM, NE_SRC, NE, 0}; tl = t - CVT_T0; }
            else if (t < CVT_T2) { c = CvtDesc{p.in[29], (bf16_t*)(ws + WS_WINO), DM, NO_SRC, NO, 1}; tl = t - CVT_T1; }
            else if (t < CVT_T3) { c = CvtDesc{p.in[13], (bf16_t*)(ws + WS_WOUT0), DM, DM, DM, 0}; tl = t - CVT_T2; }
            else if (t < CVT_T4) { c = CvtDesc{p.in[30], (bf16_t*)(ws + WS_WOUT1), DM, DM, DM, 0}; tl = t - CVT_T3; }
            else if (t < CVT_T5) { c = CvtDesc{p.in[8], (bf16_t*)(ws + WS_WUP0), DM, UPN, UPN, 0}; tl = t - CVT_T4; }
            else if (t < CVT_T6) { c = CvtDesc{p.in[8] + (size_t)DM * UPN, (bf16_t*)(ws + WS_WUP1), DM, UPN, UPN, 0}; tl = t - CVT_T5; }
            else if (t < CVT_T7) { c = CvtDesc{p.in[10], (bf16_t*)(ws + WS_WDN0), FFN, DM, DM, 0}; tl = t - CVT_T6; }
            else if (t < CVT_T8) { c = CvtDesc{p.in[10] + (size_t)FFN * DM, (bf16_t*)(ws + WS_WDN1), FFN, DM, DM, 0}; tl = t - CVT_T7; }
            else                 { c = CvtDesc{p.in[22], (bf16_t*)(ws + WS_WGLU), 512, 512, 512, 0}; tl = t - CVT_T8; }
            const int nkt = c.K / 64, tn = tl / nkt, tk = tl % nkt, n0 = tn * 256, k0 = tk * 64;
            { const int n4 = (tid & 63) * 4, kb = tid >> 6; const int sc = cvt_srccol(c.mode, n0 + n4, c.Nsrc);
              f32x4 v[8];
#pragma unroll
              for (int i = 0; i < 8; ++i) { const int k = i * 8 + kb; v[i] = (sc >= 0) ? *(const f32x4*)(c.src + (size_t)(k0 + k) * c.Nsrc + sc) : (f32x4){0.f, 0.f, 0.f, 0.f}; }
#pragma unroll
              for (int i = 0; i < 8; ++i) { const int k = i * 8 + kb; *(f32x4*)(lds + k * CVT_PITCH + n4) = v[i]; } }
            __syncthreads();
            { const int n = tid >> 1, kh = tid & 1; const float* col = lds + (kh * 32) * CVT_PITCH + n;
              bf16_t* dp = c.dst + (size_t)(n0 + n) * c.K + k0 + kh * 32;
#pragma unroll
              for (int q = 0; q < 4; ++q) { float v[8];
#pragma unroll
                  for (int i = 0; i < 8; ++i) v[i] = col[(q * 8 + i) * CVT_PITCH];
                  st8(dp + q * 8, v); } }
            __syncthreads();
        }
    }
}

__device__ void phase_modreduce(CP& p) {
    OPQ_IDS;
    const float* mp = (const float*)(p.ws + WS_MODP); float* mf = (float*)(p.ws + WS_MODF);
    for (int idx = bid_ * NTHR + tid_; idx < 2 * 5 * MODN; idx += gridDim.x * NTHR) {
        const int layer = idx / (5 * MODN), rem = idx % (5 * MODN), col = rem % MODN;
        float s = p.in[5][layer * MODN + col];
#pragma unroll
        for (int kc = 0; kc < 32; ++kc) s += mp[((size_t)(kc * 2 + layer) * 5) * MODN + rem];
        mf[idx] = s;
    }
}

__device__ void phase_norm(CP& p, int layer, int which, int nrows, bool from_input) {
    OPQ_IDS;
    const int lane = tid_ & 63, wid = tid_ >> 6;
    const float* xc = (const float*)(p.ws + WS_XC); bf16_t* act = (bf16_t*)(p.ws + WS_ACT);
    const float* nw = (which ? p.in[7] : p.in[6]) + layer * DM;
    const float* mf = (const float*)(p.ws + WS_MODF) + (size_t)layer * 5 * MODN;
    for (int row = bid_ * 8 + wid; row < nrows; row += gridDim.x * 8) {
        const float* src; int r;
        if (row < MLAT) { src = (from_input ? p.in[0] : p.out) + (size_t)row * DM; r = row >> 12; }
        else { src = (from_input ? p.in[2] : xc) + (size_t)(row - MLAT) * DM; r = 4; }
        const float* sh = mf + (size_t)r * MODN + (which ? 3 : 0) * DM; const float* sc = mf + (size_t)r * MODN + (which ? 4 : 1) * DM;
        f32x4 v[8]; float ss = 0.f;
#pragma unroll
        for (int j = 0; j < 8; ++j) { v[j] = *(const f32x4*)(src + j * 256 + lane * 4); ss += v[j][0] * v[j][0] + v[j][1] * v[j][1] + v[j][2] * v[j][2] + v[j][3] * v[j][3]; }
        ss = red64(ss);
        const float rs = rsqrtf(ss * (1.f / DM) + 1e-6f);
#pragma unroll
        for (int j = 0; j < 8; ++j) { const int col = j * 256 + lane * 4;
            const f32x4 w4 = *(const f32x4*)(nw + col), s4 = *(const f32x4*)(sh + col), c4 = *(const f32x4*)(sc + col);
            const f32x4 o = (v[j] * rs * w4) * (c4 + 1.f) + s4;
            u32x2 w; w.x = pack2(o[0], o[1]); w.y = pack2(o[2], o[3]);
            *(u32x2*)(act + (size_t)row * DM + col) = w; }
    }
}
__device__ void phase_final_norm(CP& p) {
    OPQ_IDS;
    const int lane = tid_ & 63, wid = tid_ >> 6;
    const float* nw = p.in[11];
    for (int row = bid_ * 8 + wid; row < MLAT; row += gridDim.x * 8) {
        float* src = p.out + (size_t)row * DM;
        f32x4 v[8]; float ss = 0.f;
#pragma unroll
        for (int j = 0; j < 8; ++j) { v[j] = *(const f32x4*)(src + j * 256 + lane * 4); ss += v[j][0] * v[j][0] + v[j][1] * v[j][1] + v[j][2] * v[j][2] + v[j][3] * v[j][3]; }
        ss = red64(ss);
        const float rs = rsqrtf(ss * (1.f / DM) + 1e-6f);
#pragma unroll
        for (int j = 0; j < 8; ++j) { const int col = j * 256 + lane * 4; const f32x4 w4 = *(const f32x4*)(nw + col); *(f32x4*)(src + col) = v[j] * rs * w4; }
    }
}

__device__ void phase_ffnconv(CP& p, int layer, int nrows) {
    OPQ_IDS;
    bf16_t* big = (bf16_t*)(p.ws + WS_BIG);
    const float* cw = p.in[9] + (size_t)layer * 9 * FFN;
    const int nseg = nrows / 32; constexpr int NCG = FFN / 8;
    struct F8 { f32x4 lo, hi; };
    for (long it = (long)bid_ * NTHR + tid_; it < (long)nseg * NCG; it += (long)gridDim.x * NTHR) {
        const int seg = (int)(it / NCG), cgp = (int)(it % NCG), c0 = cgp * 8, row0 = seg * 32;
        const bool lat = row0 < MLAT;
        const int W = lat ? 64 : 256;
        const int x0 = lat ? (row0 & 63) : ((row0 - MLAT) & 255);
        const int y = lat ? ((row0 & 4095) >> 6) : 0;
        const bool up_ok = lat && y > 0, dn_ok = lat && y < 63;
        F8 w[9];
#pragma unroll
        for (int q = 0; q < 9; ++q) { w[q].lo = *(const f32x4*)(cw + (size_t)q * FFN + c0); w[q].hi = *(const f32x4*)(cw + (size_t)q * FFN + c0 + 4); }
        F8 L[3], M[3], R[3];
        auto ldcol = [&](int row, bool ok, F8 (&dst)[3]) {
#pragma unroll
            for (int dy = 0; dy < 3; ++dy) {
                const bool rok = ok && (dy == 1 || (dy == 0 ? up_ok : dn_ok));
                if (rok) { const u32x4 raw = *(const u32x4*)(big + (size_t)(row + (dy - 1) * 64) * UPN + c0);
                    dst[dy].lo = (f32x4){lo16(raw.x), hi16(raw.x), lo16(raw.y), hi16(raw.y)}; dst[dy].hi = (f32x4){lo16(raw.z), hi16(raw.z), lo16(raw.w), hi16(raw.w)}; }
                else { dst[dy].lo = (f32x4){0.f, 0.f, 0.f, 0.f}; dst[dy].hi = (f32x4){0.f, 0.f, 0.f, 0.f}; }
            }
        };
        ldcol(row0 - 1, x0 > 0, L);
        ldcol(row0, true, M);
#pragma unroll 4
        for (int i = 0; i < 32; ++i) {
            const int row = row0 + i;
            ldcol(row + 1, (x0 + i + 1) < W, R);
            f32x4 a = (f32x4){0.f, 0.f, 0.f, 0.f}, bq = (f32x4){0.f, 0.f, 0.f, 0.f};
#pragma unroll
            for (int dy = 0; dy < 3; ++dy) { a += L[dy].lo * w[dy * 3 + 0].lo + M[dy].lo * w[dy * 3 + 1].lo + R[dy].lo * w[dy * 3 + 2].lo;
                bq += L[dy].hi * w[dy * 3 + 0].hi + M[dy].hi * w[dy * 3 + 1].hi + R[dy].hi * w[dy * 3 + 2].hi; }
            bf16_t* vp = big + (size_t)row * UPN + FFN + c0;
            const u32x4 vraw = *(const u32x4*)vp;
            u32x4 o;
            o.x = pack2(siluf_(a[0]) * lo16(vraw.x), siluf_(a[1]) * hi16(vraw.x)); o.y = pack2(siluf_(a[2]) * lo16(vraw.y), siluf_(a[3]) * hi16(vraw.y));
            o.z = pack2(siluf_(bq[0]) * lo16(vraw.z), siluf_(bq[1]) * hi16(vraw.z)); o.w = pack2(siluf_(bq[2]) * lo16(vraw.w), siluf_(bq[3]) * hi16(vraw.w));
            *(u32x4*)vp = o;
#pragma unroll
            for (int dy = 0; dy < 3; ++dy) { L[dy] = M[dy]; M[dy] = R[dy]; }
        }
    }
}

__device__ __forceinline__ int seg_len(int seg) { return seg ? SEQ : CTXL; }
__device__ __forceinline__ int seg_base(int seg, int b) { return seg ? b * SEQ : MLAT + b * CTXL; }

template <bool CONV, int NI = 10> struct StageRaw { u32x2 x0[NI]; u32x2 xm[CONV ? NI : 1]; u32x2 xp[CONV ? NI : 1]; };
__device__ __forceinline__ void chunk_pos(int cidx, int b, int& len, int& rowbase, int& c0) { if (cidx < 4) { len = CTXL; rowbase = MLAT + b * CTXL; c0 = cidx * 64; } else { len = SEQ; rowbase = b * SEQ; c0 = (cidx - 4) * 64; } }
template <bool CONV, int NI, class ColMap>
__device__ __forceinline__ void stage_load(StageRaw<CONV, NI>& r, const bf16_t* proj, int ldp, int rowbase, int len, int c0, int d, ColMap colmap, int tid_) {
    constexpr int NQ = NI * 8;
    asm volatile("" : "+v"(tid_));
#pragma unroll
    for (int k = 0; k < NI; ++k) {
        const int it = tid_ + k * NTHR, i = it / NQ, ch = (it % NQ) * 4;
        const int pi = c0 + i, t = d ? (len - 1 - pi) : pi;
        const bf16_t* pp = proj + (size_t)(rowbase + t) * ldp + colmap(ch);
        r.x0[k] = *(const u32x2*)pp;
        if (CONV) { r.xm[k] = *(const u32x2*)(pp - (t > 0 ? ldp : 0)); r.xp[k] = *(const u32x2*)(pp + (t < len - 1 ? ldp : 0)); }
    }
}
template <bool CONV, int NI>
__device__ __forceinline__ f32x4 stage_value(const StageRaw<CONV, NI>& r, int k, int i, int ch, int len, int c0, int d, const float* scw, const float* scb) {
    constexpr int NCH = NI * 32;
    const u32x2 x0 = r.x0[k];
    const f32x4 f0 = (f32x4){lo16(x0.x), hi16(x0.x), lo16(x0.y), hi16(x0.y)};
    if (!CONV) return f0;
    const int pi = c0 + i, t = d ? (len - 1 - pi) : pi;
    const bool mok = (t > 0), pok = (t < len - 1);
    const u32x2 xm = r.xm[k], xp = r.xp[k];
    const f32x4 fm = mok ? (f32x4){lo16(xm.x), hi16(xm.x), lo16(xm.y), hi16(xm.y)} : (f32x4){0.f, 0.f, 0.f, 0.f};
    const f32x4 fp = pok ? (f32x4){lo16(xp.x), hi16(xp.x), lo16(xp.y), hi16(xp.y)} : (f32x4){0.f, 0.f, 0.f, 0.f};
    f32x4 v = *(const f32x4*)(scb + ch) + *(const f32x4*)(scw + ch) * fm + *(const f32x4*)(scw + NCH + ch) * f0 + *(const f32x4*)(scw + 2 * NCH + ch) * fp;
    v[0] = siluf_(v[0]); v[1] = siluf_(v[1]); v[2] = siluf_(v[2]); v[3] = siluf_(v[3]);
    return v;
}
template <bool CONV, int NI>
__device__ __forceinline__ void stage_store(const StageRaw<CONV, NI>& r, int len, int c0, int d, const float* scw, const float* scb, float* srow, int tid_) {
    constexpr int NQ = NI * 8, NCH = NI * 32;
    asm volatile("" : "+v"(tid_));
#pragma unroll
    for (int k = 0; k < NI; ++k) {
        const int it = tid_ + k * NTHR, i = it / NQ, ch = (it % NQ) * 4;
        *(f32x4*)(srow + i * NCH + ch) = stage_value<CONV, NI>(r, k, i, ch, len, c0, d, scw, scb);
    }
}

__device__ void scan_ssd(CP& p, unsigned char* shm, int id) {
    OPQ_IDS;
    const int tid = tid_;
    const int b = id / 48, rem = id % 48, h = rem >> 1, d = rem & 1, g = h / 6;
    float* srow = (float*)shm;
    float* scw = srow + 64 * 320;
    float* scb = scw + 3 * 320;
    float* sdt = scb + 320;
    float* sdec = sdt + 64;
    float* sout = sdec + 64;
    const bf16_t* proj = (const bf16_t*)(p.ws + WS_BIG);
    const float* gates = (const float*)(p.ws + WS_GATES);
    bf16_t* yd = (bf16_t*)(p.ws + WS_BIG + BIG_PROJ) + (size_t)d * MTOT * DM;
    auto colmap = [=](int ch) { return ch < 64 ? (2048 + h * 64 + ch) : (ch < 192 ? (3584 + g * 128 + (ch - 64)) : (4096 + g * 128 + (ch - 192))); };
    for (int e = tid; e < 320; e += NTHR) { const int cc = colmap(e) - 2048;
        scw[e] = p.in[23][cc]; scw[320 + e] = p.in[23][2560 + cc]; scw[640 + e] = p.in[23][2 * 2560 + cc]; scb[e] = p.in[24][cc]; }
    const float dtb = p.in[25][d * 24 + h], aneg = -expf(p.in[26][d * 24 + h]);
    const int ns = tid & 15, pp = tid >> 4;
    float s0[8], s1[8];
#pragma unroll
    for (int j = 0; j < 8; ++j) { s0[j] = 0.f; s1[j] = 0.f; }
    __syncthreads();
    StageRaw<true, 10> raw; float graw = 0.f;
    { int len, rowbase, c0; chunk_pos(0, b, len, rowbase, c0); stage_load<true, 10>(raw, proj, NE_MAIN, rowbase, len, c0, d, colmap, tid_);
      if (tid_ < 64) { const int pi = c0 + tid_, t = d ? (len - 1 - pi) : pi; graw = gates[(size_t)(rowbase + t) * 64 + d * 24 + h]; } }
    for (int cidx = 0; cidx < 68; ++cidx) {
        int len, rowbase, c0; chunk_pos(cidx, b, len, rowbase, c0);
        {
            stage_store<true, 10>(raw, len, c0, d, scw, scb, srow, tid_);
            if (tid_ < 64) { const float dt = softplusf_(graw + dtb); sdt[tid_] = dt; sdec[tid_] = expf(dt * aneg); }
            __syncthreads();
            if (cidx + 1 < 68) { int len2, rowbase2, c02; chunk_pos(cidx + 1, b, len2, rowbase2, c02); stage_load<true, 10>(raw, proj, NE_MAIN, rowbase2, len2, c02, d, colmap, tid_);
                if (tid_ < 64) { const int pi = c02 + tid_, t = d ? (len2 - 1 - pi) : pi; graw = gates[(size_t)(rowbase2 + t) * 64 + d * 24 + h]; } }
            {
                const float* rp0 = srow;
                float dec_n = sdec[0], dtv_n = sdt[0]; float2 xv_n = *(const float2*)(rp0 + 2 * pp);
                f32x4 B0n = *(const f32x4*)(rp0 + 64 + ns * 8), B1n = *(const f32x4*)(rp0 + 64 + ns * 8 + 4), C0n = *(const f32x4*)(rp0 + 192 + ns * 8), C1n = *(const f32x4*)(rp0 + 192 + ns * 8 + 4);
                for (int i = 0; i < 64; ++i) {
                    const float dec = dec_n, dtv = dtv_n; const float2 xv = xv_n; const f32x4 B0 = B0n, B1 = B1n, C0 = C0n, C1 = C1n;
                    if (i < 63) { const float* rp = srow + (i + 1) * 320; dec_n = sdec[i + 1]; dtv_n = sdt[i + 1]; xv_n = *(const float2*)(rp + 2 * pp);
                        B0n = *(const f32x4*)(rp + 64 + ns * 8); B1n = *(const f32x4*)(rp + 64 + ns * 8 + 4); C0n = *(const f32x4*)(rp + 192 + ns * 8); C1n = *(const f32x4*)(rp + 192 + ns * 8 + 4); }
                    const float x0 = xv.x * dtv, x1 = xv.y * dtv;
                    float y0a = 0.f, y0b = 0.f, y1a = 0.f, y1b = 0.f;
#pragma unroll
                    for (int j = 0; j < 4; ++j) {
                        s0[j] = s0[j] * dec + x0 * B0[j]; s1[j] = s1[j] * dec + x1 * B0[j]; y0a += s0[j] * C0[j]; y1a += s1[j] * C0[j];
                        s0[4 + j] = s0[4 + j] * dec + x0 * B1[j]; s1[4 + j] = s1[4 + j] * dec + x1 * B1[j]; y0b += s0[4 + j] * C1[j]; y1b += s1[4 + j] * C1[j]; }
                    const float y0 = red16(y0a + y0b), y1 = red16(y1a + y1b);
                    if (ns == 0) *(float2*)(sout + i * 64 + 2 * pp) = make_float2(y0, y1);
                }
            }
            __syncthreads();
            { const int i = tid_ >> 3, c8 = (tid_ & 7) * 8, pi = c0 + i, t = d ? (len - 1 - pi) : pi; float o[8]; ldf8(sout + i * 64 + c8, o);
              st8(yd + (size_t)(rowbase + t) * DM + 512 + h * 64 + c8, o); }
        }
    }
}

__device__ void scan_s5(CP& p, unsigned char* shm, int id2) {
    OPQ_IDS;
    const int tid = tid_, sl = tid >> 7, j = tid & 127, st = j >> 1, part = j & 1;
    const int s = id2 * 4 + sl, b = s >> 6, rem = s & 63, g = rem >> 1, d = rem & 1;
    float* su = (float*)shm + sl * (32 * 16);
    float* sX = (float*)shm + 4 * 32 * 16 + sl * (32 * 132);
    float* sC = (float*)shm + 4 * 32 * 16 + 4 * 32 * 132 + sl * (128 * 16);
    const bf16_t* proj = (const bf16_t*)(p.ws + WS_BIG);
    bf16_t* yd = (bf16_t*)(p.ws + WS_BIG + BIG_PROJ) + (size_t)d * MTOT * DM;
    const int dg = d * 32 + g;
    const float lr = p.in[14][dg * 64 + st], li = p.in[15][dg * 64 + st], step = expf(p.in[16][dg]);
    const float ea = lr * step, eb = li * step, mag = expf(ea), cb = cosf(eb), sb = sinf(eb), shb = sinf(0.5f * eb);
    const float lbr = mag * cb, lbi = mag * sb;
    const float nr = expm1f(ea) * cb - 2.f * shb * shb, ni = lbi;
    const float den = lr * lr + li * li;
    const float qr = (nr * lr + ni * li) / den, qi = (ni * lr - nr * li) / den;
    float Bb[16];
#pragma unroll
    for (int hh = 0; hh < 16; ++hh) { const float br = p.in[17][(size_t)(dg * 64 + st) * 16 + hh], bi = p.in[18][(size_t)(dg * 64 + st) * 16 + hh];
        Bb[hh] = part ? (qr * bi + qi * br) : (qr * br - qi * bi); }
#pragma unroll
    for (int hh = 0; hh < 16; ++hh) sC[j * 16 + hh] = part ? -p.in[20][(size_t)(dg * 16 + hh) * 64 + st] : p.in[19][(size_t)(dg * 16 + hh) * 64 + st];
    const float lis = part ? lbi : -lbi;
    float x = 0.f;
    __syncthreads();
    for (int seg = 0; seg < 2; ++seg) {
        const int len = seg_len(seg), rowbase = seg_base(seg, b);
        for (int c0 = 0; c0 < len; c0 += 32) {
            { const int i = j >> 2, hq = j & 3, pi = c0 + i, t = d ? (len - 1 - pi) : pi;
              const u32x2 raw = *(const u32x2*)(proj + (size_t)(rowbase + t) * NE_MAIN + g * 16 + hq * 4);
              *(f32x4*)(su + i * 16 + hq * 4) = (f32x4){lo16(raw.x), hi16(raw.x), lo16(raw.y), hi16(raw.y)}; }
            __syncthreads();
            for (int i = 0; i < 32; ++i) {
                const f32x4 u0 = *(const f32x4*)(su + i * 16), u1 = *(const f32x4*)(su + i * 16 + 4), u2 = *(const f32x4*)(su + i * 16 + 8), u3 = *(const f32x4*)(su + i * 16 + 12);
                float bu = 0.f;
#pragma unroll
                for (int q = 0; q < 4; ++q) bu += Bb[q] * u0[q] + Bb[4 + q] * u1[q] + Bb[8 + q] * u2[q] + Bb[12 + q] * u3[q];
                const float xp = dppmov<0xB1>(x);
                x = lbr * x + lis * xp + bu;
                sX[i * 132 + j] = x;
            }
            __syncthreads();
            { const int i = j >> 2, hq = j & 3, pi = c0 + i, t = d ? (len - 1 - pi) : pi;
              f32x4 acc = (f32x4){0.f, 0.f, 0.f, 0.f};
              for (int jj = 0; jj < 128; jj += 4) { const f32x4 xv = *(const f32x4*)(sX + i * 132 + jj);
#pragma unroll
                  for (int q = 0; q < 4; ++q) acc += *(const f32x4*)(sC + (jj + q) * 16 + hq * 4) * xv[q]; }
              u32x2 o; o.x = pack2(acc[0], acc[1]); o.y = pack2(acc[2], acc[3]);
              *(u32x2*)(yd + (size_t)(rowbase + t) * DM + g * 16 + hq * 4) = o; }
        }
    }
}

__device__ void scan_gdn(CP& p, unsigned char* shm, int id) {
    OPQ_IDS;
    const int tid = tid_, lane = tid & 63, wid = tid >> 6;
    const int b = id >> 5, rem = id & 31, h = rem >> 2, d = (rem >> 1) & 1, vh = rem & 1;
    float* srow = (float*)shm;
    float* scw = srow + 64 * 320;
    float* scb = scw + 3 * 320;
    float* srq = scb + 320;
    float* srk = srq + 64;
    float* sa = srk + 64;
    float* sbt = sa + 64;
    float* sout = sbt + 64;
    const bf16_t* proj = (const bf16_t*)(p.ws + WS_BIG);
    const float* gates = (const float*)(p.ws + WS_GATES);
    bf16_t* yd = (bf16_t*)(p.ws + WS_BIG + BIG_PROJ) + (size_t)d * MTOT * DM;
    auto colmap = [=](int ch) { return ch < 128 ? (h * 128 + ch) : (ch < 256 ? (1024 + h * 128 + (ch - 128)) : (2048 + h * 128 + vh * 64 + (ch - 256))); };
    for (int e = tid; e < 320; e += NTHR) { const int cc = colmap(e);
        scw[e] = p.in[31][cc]; scw[320 + e] = p.in[31][3072 + cc]; scw[640 + e] = p.in[31][2 * 3072 + cc]; scb[e] = 0.f; }
    const float dtb = p.in[32][d * 8 + h], aexp = -expf(p.in[33][d * 8 + h]);
    const int ks = tid & 7, col = tid >> 3;
    float S[16];
#pragma unroll
    for (int jx = 0; jx < 16; ++jx) S[jx] = 0.f;
    __syncthreads();
    StageRaw<true, 10> raw; float graw0 = 0.f, graw1 = 0.f;
    { int len, rowbase, c0; chunk_pos(0, b, len, rowbase, c0); stage_load<true, 10>(raw, proj, NO_MAIN, rowbase, len, c0, d, colmap, tid_);
      if (tid_ < 64) { const int pi = c0 + tid_, t = d ? (len - 1 - pi) : pi; const float* gp = gates + (size_t)(rowbase + t) * 64; graw0 = gp[d * 8 + h]; graw1 = gp[16 + d * 8 + h]; } }
    for (int cidx = 0; cidx < 68; ++cidx) {
        int len, rowbase, c0; chunk_pos(cidx, b, len, rowbase, c0);
        {
            stage_store<true, 10>(raw, len, c0, d, scw, scb, srow, tid_);
            if (tid_ < 64) { sbt[tid_] = sigmoidf_(graw0); sa[tid_] = expf(aexp * softplusf_(graw1 + dtb)); }
            __syncthreads();
            if (cidx + 1 < 68) { int len2, rowbase2, c02; chunk_pos(cidx + 1, b, len2, rowbase2, c02); stage_load<true, 10>(raw, proj, NO_MAIN, rowbase2, len2, c02, d, colmap, tid_);
                if (tid_ < 64) { const int pi = c02 + tid_, t = d ? (len2 - 1 - pi) : pi; const float* gp = gates + (size_t)(rowbase2 + t) * 64; graw0 = gp[d * 8 + h]; graw1 = gp[16 + d * 8 + h]; } }
            for (int i = wid; i < 64; i += 8) { const float* rp = srow + i * 320;
                float q2 = rp[lane] * rp[lane] + rp[64 + lane] * rp[64 + lane], k2 = rp[128 + lane] * rp[128 + lane] + rp[192 + lane] * rp[192 + lane];
                q2 = red64(q2); k2 = red64(k2);
                if (lane == 0) { srq[i] = rsqrtf(q2 + 1e-6f) * 0.08838834764831845f; srk[i] = rsqrtf(k2 + 1e-6f); } }
            __syncthreads();
            {
                float a_n = sa[0], bt_n = sbt[0], rk_n = srk[0], rq_n = srq[0], vv_n = srow[256 + col];
                f32x4 kkn[4], qqn[4];
#pragma unroll
                for (int q = 0; q < 4; ++q) { kkn[q] = *(const f32x4*)(srow + 128 + ks * 16 + q * 4); qqn[q] = *(const f32x4*)(srow + ks * 16 + q * 4); }
                for (int i = 0; i < 64; ++i) {
                    const float a = a_n, bt = bt_n, rk = rk_n, rq = rq_n, vv = vv_n;
                    f32x4 kk[4], qq[4];
#pragma unroll
                    for (int q = 0; q < 4; ++q) { kk[q] = kkn[q]; qq[q] = qqn[q]; }
                    if (i < 63) { const float* rp = srow + (i + 1) * 320; a_n = sa[i + 1]; bt_n = sbt[i + 1]; rk_n = srk[i + 1]; rq_n = srq[i + 1]; vv_n = rp[256 + col];
#pragma unroll
                        for (int q = 0; q < 4; ++q) { kkn[q] = *(const f32x4*)(rp + 128 + ks * 16 + q * 4); qqn[q] = *(const f32x4*)(rp + ks * 16 + q * 4); } }
                    float dq[4];
#pragma unroll
                    for (int q = 0; q < 4; ++q) dq[q] = kk[q][0] * S[q * 4] + kk[q][1] * S[q * 4 + 1] + kk[q][2] * S[q * 4 + 2] + kk[q][3] * S[q * 4 + 3];
                    const float dd = red8((dq[0] + dq[1]) + (dq[2] + dq[3])) * rk;
                    const float w = bt * (vv - a * dd) * rk;
                    float oq[4];
#pragma unroll
                    for (int q = 0; q < 4; ++q) {
#pragma unroll
                        for (int e = 0; e < 4; ++e) S[q * 4 + e] = a * S[q * 4 + e] + kk[q][e] * w;
                        oq[q] = qq[q][0] * S[q * 4] + qq[q][1] * S[q * 4 + 1] + qq[q][2] * S[q * 4 + 2] + qq[q][3] * S[q * 4 + 3]; }
                    const float o = red8((oq[0] + oq[1]) + (oq[2] + oq[3])) * rq;
                    if (ks == 0) sout[i * 64 + col] = o;
                }
            }
            __syncthreads();
            { const int i = tid_ >> 3, c8 = (tid_ & 7) * 8, pi = c0 + i, t = d ? (len - 1 - pi) : pi; float o[8]; ldf8(sout + i * 64 + c8, o);
              st8(yd + (size_t)(rowbase + t) * DM + h * 128 + vh * 64 + c8, o); }
        }
    }
}

__device__ void scan_mlstm(CP& p, unsigned char* shm, int id) {
    OPQ_IDS;
    const int tid = tid_, lane = tid & 63, wid = tid >> 6;
    const int b = id >> 5, rem = id & 31, h = rem >> 3, d = (rem >> 2) & 1, vq = rem & 3;
    float* srow = (float*)shm;
    float* sf = srow + 64 * 320;
    float* se = sf + 64;
    float* sout = se + 64;
    float* sden = sout + 64 * 64;
    const bf16_t* proj = (const bf16_t*)(p.ws + WS_BIG);
    const float* gates = (const float*)(p.ws + WS_GATES);
    bf16_t* yd = (bf16_t*)(p.ws + WS_BIG + BIG_PROJ) + (size_t)d * MTOT * DM;
    float* den = (float*)(p.ws + WS_DEN) + (size_t)d * MTOT * 4;
    auto colmap = [=](int ch) { return ch < 128 ? (4096 + h * 128 + ch) : (ch < 256 ? (4608 + h * 128 + (ch - 128)) : (5120 + h * 256 + vq * 64 + (ch - 256))); };
    const float ib = p.in[35][d * 4 + h], fb = p.in[36][d * 4 + h];
    const int ks = tid & 7, col = tid >> 3;
    const bool do_den = (vq == 0) && (wid == 0);
    float C[16];
#pragma unroll
    for (int jx = 0; jx < 16; ++jx) C[jx] = 0.f;
    float n0 = 0.f, n1 = 0.f;
    const float ksc = 0.08838834764831845f;
    StageRaw<false, 10> raw; float graw0 = 0.f, graw1 = 0.f;
    { int len, rowbase, c0; chunk_pos(0, b, len, rowbase, c0); stage_load<false, 10>(raw, proj, NO_MAIN, rowbase, len, c0, d, colmap, tid_);
      if (tid_ < 64) { const int pi = c0 + tid_, t = d ? (len - 1 - pi) : pi; const float* gp = gates + (size_t)(rowbase + t) * 64; graw0 = gp[32 + d * 4 + h]; graw1 = gp[40 + d * 4 + h]; } }
    for (int cidx = 0; cidx < 68; ++cidx) {
        int len, rowbase, c0; chunk_pos(cidx, b, len, rowbase, c0);
        {
            stage_store<false, 10>(raw, len, c0, d, (const float*)nullptr, (const float*)nullptr, srow, tid_);
            if (tid_ < 64) { se[tid_] = expf(graw0 + ib); sf[tid_] = sigmoidf_(graw1 + fb); }
            __syncthreads();
            if (cidx + 1 < 68) { int len2, rowbase2, c02; chunk_pos(cidx + 1, b, len2, rowbase2, c02); stage_load<false, 10>(raw, proj, NO_MAIN, rowbase2, len2, c02, d, colmap, tid_);
                if (tid_ < 64) { const int pi = c02 + tid_, t = d ? (len2 - 1 - pi) : pi; const float* gp = gates + (size_t)(rowbase2 + t) * 64; graw0 = gp[32 + d * 4 + h]; graw1 = gp[40 + d * 4 + h]; } }
            {
                float f_n = sf[0], ei_n = se[0] * ksc, vv_n = srow[256 + col];
                f32x4 kkn[4], qqn[4];
#pragma unroll
                for (int q = 0; q < 4; ++q) { kkn[q] = *(const f32x4*)(srow + 128 + ks * 16 + q * 4); qqn[q] = *(const f32x4*)(srow + ks * 16 + q * 4); }
                for (int i = 0; i < 64; ++i) {
                    const float f = f_n, ei = ei_n, vv = vv_n;
                    f32x4 kk[4], qq[4];
#pragma unroll
                    for (int q = 0; q < 4; ++q) { kk[q] = kkn[q]; qq[q] = qqn[q]; }
                    const float* rpc = srow + i * 320;
                    if (i < 63) { const float* rp = srow + (i + 1) * 320; f_n = sf[i + 1]; ei_n = se[i + 1] * ksc; vv_n = rp[256 + col];
#pragma unroll
                        for (int q = 0; q < 4; ++q) { kkn[q] = *(const f32x4*)(rp + 128 + ks * 16 + q * 4); qqn[q] = *(const f32x4*)(rp + ks * 16 + q * 4); } }
                    const float w = ei * vv;
                    float oq[4];
#pragma unroll
                    for (int q = 0; q < 4; ++q) {
#pragma unroll
                        for (int e = 0; e < 4; ++e) C[q * 4 + e] = f * C[q * 4 + e] + kk[q][e] * w;
                        oq[q] = qq[q][0] * C[q * 4] + qq[q][1] * C[q * 4 + 1] + qq[q][2] * C[q * 4 + 2] + qq[q][3] * C[q * 4 + 3]; }
                    const float o = red8((oq[0] + oq[1]) + (oq[2] + oq[3]));
                    if (ks == 0) sout[i * 64 + col] = o;
                    if (do_den) {
                        const float2 k2 = *(const float2*)(rpc + 128 + 2 * lane), q2 = *(const float2*)(rpc + 2 * lane);
                        n0 = f * n0 + ei * k2.x; n1 = f * n1 + ei * k2.y;
                        float dn = q2.x * n0 + q2.y * n1;
                        dn = red64(dn);
                        if (lane == 0) sden[i] = dn;
                    }
                }
            }
            __syncthreads();
            { const int i = tid_ >> 3, c8 = (tid_ & 7) * 8, pi = c0 + i, t = d ? (len - 1 - pi) : pi; float o[8]; ldf8(sout + i * 64 + c8, o);
              st8(yd + (size_t)(rowbase + t) * DM + 1024 + h * 256 + vq * 64 + c8, o);
              if (vq == 0 && tid_ < 64) { const int pj = c0 + tid_, tj = d ? (len - 1 - pj) : pj; den[(size_t)(rowbase + tj) * 4 + h] = sden[tid_]; } }
        }
    }
}

constexpr int LQ = 136, LT = 72, PV = 88;
typedef short s16x4 __attribute__((ext_vector_type(4)));
__device__ __forceinline__ bf16x8 ldfrag(const bf16_t* base, int row0, int ks, int ld, int fr, int fq) { return *(const bf16x8*)(base + (row0 + fr) * ld + ks * 32 + fq * 8); }
__device__ __forceinline__ bf16x8 ldfrag_tr(const bf16_t* base, int krow0, int col0, int ld, int fr) {
    const bf16_t* a = base + (krow0 + (fr >> 2)) * ld + col0 + (fr & 3) * 4;
    const s16x4 lo = __builtin_amdgcn_ds_read_tr16_b64_v4i16((LAS s16x4*)a);
    const s16x4 hi = __builtin_amdgcn_ds_read_tr16_b64_v4i16((LAS s16x4*)(a + 4 * ld));
    return (bf16x8){lo[0], lo[1], lo[2], lo[3], hi[0], hi[1], hi[2], hi[3]};
}
__device__ __forceinline__ float softplus_fast(float x) { return fmaxf(x, 0.f) + __logf(1.f + __expf(-fabsf(x))); }
struct SsdRaw { u32x2 x0[2], xm[2], xp[2], bc[8]; };
__device__ __forceinline__ void ssd_load(SsdRaw& r, const bf16_t* proj, const bf16_t* bcbuf, int rowbase, int len, int c0, int d, int h, int g, int tid_) {
    asm volatile("" : "+v"(tid_));
#pragma unroll
    for (int k = 0; k < 2; ++k) { const int it = tid_ + k * NTHR, i = it >> 4, ch = (it & 15) * 4, pi = c0 + i, t = d ? (len - 1 - pi) : pi;
        const bf16_t* pp = proj + (size_t)(rowbase + t) * NE_MAIN + 2048 + h * 64 + ch;
        r.x0[k] = *(const u32x2*)pp; r.xm[k] = *(const u32x2*)(pp - (t > 0 ? NE_MAIN : 0)); r.xp[k] = *(const u32x2*)(pp + (t < len - 1 ? NE_MAIN : 0)); }
#pragma unroll
    for (int k = 0; k < 8; ++k) { const int it = tid_ + k * NTHR, i = it >> 6, ch = (it & 63) * 4, pi = c0 + i, t = d ? (len - 1 - pi) : pi;
        r.bc[k] = *(const u32x2*)(bcbuf + (size_t)(rowbase + t) * 1024 + (ch < 128 ? (g * 128 + ch) : (512 + g * 128 + (ch - 128)))); }
}
__device__ void ssd_bc_prepass(CP& p) {
    OPQ_IDS;
    const int lane = tid_ & 63, wid = tid_ >> 6;
    const bf16_t* proj = (const bf16_t*)(p.ws + WS_BIG); bf16_t* bc = (bf16_t*)(p.ws + WS_ACT);
    for (int row = bid_ * 8 + wid; row < MTOT; row += gridDim.x * 8) {
        int t, len;
        if (row < MLAT) { t = row & (SEQ - 1); len = SEQ; } else { t = (row - MLAT) & (CTXL - 1); len = CTXL; }
        const bf16_t* pr = proj + (size_t)row * NE_MAIN + 3584;
#pragma unroll
        for (int ps = 0; ps < 2; ++ps) { const int c = ps * 512 + lane * 8, cc = 1536 + c;
            float x0[8], xm[8], xp[8], w0[8], w1[8], w2[8], cb[8], o[8];
            ld8(pr + c, x0);
            if (t > 0) ld8(pr - NE_MAIN + c, xm); else { for (int q = 0; q < 8; ++q) xm[q] = 0.f; }
            if (t < len - 1) ld8(pr + NE_MAIN + c, xp); else { for (int q = 0; q < 8; ++q) xp[q] = 0.f; }
            ldf8(p.in[23] + cc, w0); ldf8(p.in[23] + 2560 + cc, w1); ldf8(p.in[23] + 5120 + cc, w2); ldf8(p.in[24] + cc, cb);
#pragma unroll
            for (int q = 0; q < 8; ++q) o[q] = siluf_(cb[q] + w0[q] * xm[q] + w1[q] * x0[q] + w2[q] * xp[q]);
            st8(bc + (size_t)row * 1024 + c, o); }
    }
}
template <int NVT, bool IS_SSD, int VW>
__device__ void scan_la(CP& p, unsigned char* shm, int id) {
    OPQ_IDS;
    const int lane = tid_ & 63, wid = tid_ >> 6, fr = lane & 15, fq = lane >> 4;
    int b, h, d, g = 0, vq = 0;
    if (IS_SSD) { b = id / 48; const int rem = id % 48; h = rem >> 1; d = rem & 1; g = h / 6; }
    else if (VW == 64) { b = id >> 5; const int rem = id & 31; h = rem >> 3; d = (rem >> 2) & 1; vq = rem & 3; }
    else { b = id >> 6; const int rem = id & 63; h = rem >> 4; d = (rem >> 3) & 1; vq = rem & 7; }
    bf16_t* sQ = (bf16_t*)shm;
    bf16_t* sK = sQ + 64 * LQ;
    bf16_t* sV = sK + 64 * LQ;
    bf16_t* sVw = sV + 64 * PV;
    bf16_t* sP = sVw + 64 * PV;
    bf16_t* sS = sP + 64 * LT;
    float* sout = (float*)(sS + 80 * LQ);
    float* scw = sout + 4096;
    float* scb = scw + 960;
    float* scum = scb + 320;
    float* sw = scum + 64;
    float* se = sw + 64;
    float* sden = se + 64;
    const bf16_t* proj = (const bf16_t*)(p.ws + WS_BIG);
    const float* gates = (const float*)(p.ws + WS_GATES);
    bf16_t* yd = (bf16_t*)(p.ws + WS_BIG + BIG_PROJ) + (size_t)d * MTOT * DM;
    float* den = (float*)(p.ws + WS_DEN) + (size_t)d * MTOT * 4;
    const int ldp = IS_SSD ? NE_MAIN : NO_MAIN;
    auto colmap = [=](int ch) { return IS_SSD ? (ch < 64 ? (2048 + h * 64 + ch) : (ch < 192 ? (3584 + g * 128 + (ch - 64)) : (4096 + g * 128 + (ch - 192))))
                                              : (ch < VW ? (5120 + h * 256 + vq * VW + ch) : (ch < VW + 128 ? (4608 + h * 128 + (ch - VW)) : (4096 + h * 128 + (ch - VW - 128)))); };
    if (IS_SSD) for (int e = tid_; e < 320; e += NTHR) { const int cc = colmap(e) - 2048;
        scw[e] = p.in[23][cc]; scw[320 + e] = p.in[23][2560 + cc]; scw[640 + e] = p.in[23][2 * 2560 + cc]; scb[e] = p.in[24][cc]; }
    for (int e = tid_; e < 80 * LQ; e += NTHR) sS[e] = 0;
    for (int e = tid_; e < 64 * 24; e += NTHR) { const int i = e / 24, c = VW + e % 24; sV[i * PV + c] = (c == VW) ? (bf16_t)0x3F80 : (bf16_t)0; sVw[i * PV + c] = 0; }
    float g0b, g1b;
    if (IS_SSD) { g0b = p.in[25][d * 24 + h]; g1b = -expf(p.in[26][d * 24 + h]); }
    else { g0b = p.in[35][d * 4 + h]; g1b = p.in[36][d * 4 + h]; }
    const int gcol0 = IS_SSD ? (d * 24 + h) : (32 + d * 4 + h), gcol1 = IS_SSD ? (d * 24 + h) : (40 + d * 4 + h);
    f32x4 Sacc[NVT];
#pragma unroll
    for (int vt = 0; vt < NVT; ++vt) Sacc[vt] = (f32x4){0.f, 0.f, 0.f, 0.f};
    constexpr int NIM = (VW + 256) / 32;
    StageRaw<false, NIM> raw; SsdRaw sraw; float graw0 = 0.f, graw1 = 0.f;
    const bf16_t* bcbuf = (const bf16_t*)(p.ws + WS_ACT);
    static_assert(IS_SSD || (VW == 32 && NIM == 9), "mLSTM staging layout assumes 32-column v slices");
    const int mq_i0 = tid_ >> 6, mq_ch = (tid_ & 63) * 4;
    const int mq_col = (mq_ch < 128) ? (4608 + h * 128 + mq_ch) : (4096 + h * 128 + (mq_ch - 128));
    bf16_t* const mq_dst = (mq_ch < 128) ? (sK + mq_i0 * LQ + mq_ch) : (sQ + mq_i0 * LQ + (mq_ch - 128));
    const int mv_i = tid_ >> 3, mv_ch = (tid_ & 7) * 4, mv_col = 5120 + h * 256 + vq * VW + mv_ch;
    bf16_t* const mv_dst = sV + mv_i * PV + mv_ch;
    auto mload = [&](int rowbase_, int len_, int c0_) {
#pragma unroll
        for (int k = 0; k < 8; ++k) { const int pi = c0_ + mq_i0 + 8 * k, t = d ? (len_ - 1 - pi) : pi;
            raw.x0[k] = *(const u32x2*)(proj + (size_t)((rowbase_ + t) * ldp + mq_col)); }
        { const int pi = c0_ + mv_i, t = d ? (len_ - 1 - pi) : pi; raw.x0[8] = *(const u32x2*)(proj + (size_t)((rowbase_ + t) * ldp + mv_col)); }
    };
    const int sb_i0 = tid_ >> 6, sb_ch = (tid_ & 63) * 4, sb_col = (sb_ch < 128) ? (g * 128 + sb_ch) : (512 + g * 128 + (sb_ch - 128));
    bf16_t* const sb_dst = (sb_ch < 128) ? (sK + sb_i0 * LQ + sb_ch) : (sQ + sb_i0 * LQ + (sb_ch - 128));
    const int sx_i0 = tid_ >> 4, sx_ch = (tid_ & 15) * 4, sx_col = 2048 + h * 64 + sx_ch;
    bf16_t* const sx_dst = sV + sx_i0 * PV + sx_ch;
    auto sload = [&](int rowbase_, int len_, int c0_) {
#pragma unroll
        for (int k = 0; k < 2; ++k) { const int pi = c0_ + sx_i0 + 32 * k, t = d ? (len_ - 1 - pi) : pi;
            const bf16_t* pp = proj + (size_t)((rowbase_ + t) * NE_MAIN + sx_col);
            sraw.x0[k] = *(const u32x2*)pp; sraw.xm[k] = *(const u32x2*)(pp - (t > 0 ? NE_MAIN : 0)); sraw.xp[k] = *(const u32x2*)(pp + (t < len_ - 1 ? NE_MAIN : 0)); }
#pragma unroll
        for (int k = 0; k < 8; ++k) { const int pi = c0_ + sb_i0 + 8 * k, t = d ? (len_ - 1 - pi) : pi;
            sraw.bc[k] = *(const u32x2*)(bcbuf + (size_t)((rowbase_ + t) * 1024 + sb_col)); }
    };
    { int len, rowbase, c0; chunk_pos(0, b, len, rowbase, c0);
      if (IS_SSD) sload(rowbase, len, c0); else mload(rowbase, len, c0);
      if (tid_ < 64) { const int pi = c0 + tid_, t = d ? (len - 1 - pi) : pi; const float* gp = gates + (size_t)(rowbase + t) * 64; graw0 = gp[gcol0]; graw1 = gp[gcol1]; } }
    __syncthreads();
    const int rt = wid & 3, wh = wid >> 2;
    for (int cidx = 0; cidx < 68; ++cidx) {
        int len, rowbase, c0; chunk_pos(cidx, b, len, rowbase, c0);
        if (wid == 0) {
            float lf, e;
            if (IS_SSD) { const float dt = softplus_fast(graw0 + g0b); lf = dt * g1b; e = dt; }
            else { e = __expf(graw0 + g0b) * 0.08838834764831845f; lf = -softplus_fast(-(graw1 + g1b)); }
            float c = lf;
#pragma unroll
            for (int off = 1; off < 64; off <<= 1) { const float t2 = __shfl_up(c, off, 64); if (lane >= off) c += t2; }
            const float cend = __shfl(c, 63, 64);
            const float wj = e * __expf(cend - c);
            scum[lane] = c; se[lane] = e; sw[lane] = wj;
            if (!IS_SSD) sVw[lane * PV + VW] = f2bf(wj);
        }
        __syncthreads();
        if (IS_SSD) {
            const f32x4 cwb = *(const f32x4*)(scb + sx_ch), cwm = *(const f32x4*)(scw + sx_ch), cw0 = *(const f32x4*)(scw + 320 + sx_ch), cwp = *(const f32x4*)(scw + 640 + sx_ch);
#pragma unroll
            for (int k = 0; k < 2; ++k) {
                const int i = sx_i0 + 32 * k, pi = c0 + i, t = d ? (len - 1 - pi) : pi;
                const u32x2 x0 = sraw.x0[k], xm = sraw.xm[k], xp = sraw.xp[k];
                const f32x4 f0 = (f32x4){lo16(x0.x), hi16(x0.x), lo16(x0.y), hi16(x0.y)};
                const f32x4 fm = (t > 0) ? (f32x4){lo16(xm.x), hi16(xm.x), lo16(xm.y), hi16(xm.y)} : (f32x4){0.f, 0.f, 0.f, 0.f};
                const f32x4 fp = (t < len - 1) ? (f32x4){lo16(xp.x), hi16(xp.x), lo16(xp.y), hi16(xp.y)} : (f32x4){0.f, 0.f, 0.f, 0.f};
                f32x4 v = cwb + cwm * fm + cw0 * f0 + cwp * fp;
                v[0] = siluf_(v[0]); v[1] = siluf_(v[1]); v[2] = siluf_(v[2]); v[3] = siluf_(v[3]);
                const float wi = sw[i];
                u32x2 w2, w3; w2.x = pack2(v[0], v[1]); w2.y = pack2(v[2], v[3]); w3.x = pack2(v[0] * wi, v[1] * wi); w3.y = pack2(v[2] * wi, v[3] * wi);
                *(u32x2*)(sx_dst + k * 32 * PV) = w2; *(u32x2*)(sx_dst + k * 32 * PV + 64 * PV) = w3;
            }
#pragma unroll
            for (int k = 0; k < 8; ++k) *(u32x2*)(sb_dst + k * 8 * LQ) = sraw.bc[k];
        } else {
#pragma unroll
            for (int k = 0; k < 8; ++k) *(u32x2*)(mq_dst + k * 8 * LQ) = raw.x0[k];
            { const u32x2 w2 = raw.x0[8]; const float wi = sw[mv_i];
              u32x2 w3; w3.x = pack2(lo16(w2.x) * wi, hi16(w2.x) * wi); w3.y = pack2(lo16(w2.y) * wi, hi16(w2.y) * wi);
              *(u32x2*)mv_dst = w2; *(u32x2*)(mv_dst + 64 * PV) = w3; }
        }
        __syncthreads();
        if (cidx + 1 < 68) { int len2, rowbase2, c02; chunk_pos(cidx + 1, b, len2, rowbase2, c02);
            if (IS_SSD) sload(rowbase2, len2, c02); else mload(rowbase2, len2, c02);
            if (tid_ < 64) { const int pi = c02 + tid_, t = d ? (len2 - 1 - pi) : pi; const float* gp = gates + (size_t)(rowbase2 + t) * 64; graw0 = gp[gcol0]; graw1 = gp[gcol1]; } }
        const float cend = scum[63];
        const f32x4 crow = *(const f32x4*)(scum + rt * 16 + fq * 4);
        const f32x4 erow = (f32x4){__expf(crow[0]), __expf(crow[1]), __expf(crow[2]), __expf(crow[3])};
        bf16x8 aq[4];
#pragma unroll
        for (int ks = 0; ks < 4; ++ks) aq[ks] = ldfrag(sQ, rt * 16, ks, LQ, fr, fq);
#pragma unroll
        for (int c2 = 0; c2 < 2; ++c2) {
            const int ct = wh * 2 + c2;
            f32x4 pacc = (f32x4){0.f, 0.f, 0.f, 0.f};
#pragma unroll
            for (int ks = 0; ks < 4; ++ks) pacc = __builtin_amdgcn_mfma_f32_16x16x32_bf16(aq[ks], ldfrag(sK, ct * 16, ks, LQ, fr, fq), pacc, 0, 0, 0);
            const int jj = ct * 16 + fr; const float cj = scum[jj], ej = se[jj];
#pragma unroll
            for (int r = 0; r < 4; ++r) { const int ii = rt * 16 + fq * 4 + r;
                const float val = (jj <= ii) ? pacc[r] * __expf(crow[r] - cj) * ej : 0.f;
                sP[ii * LT + jj] = f2bf(val); }
        }
        f32x4 oacc[3];
#pragma unroll
        for (int v3 = 0; v3 < 3; ++v3) {
            const int vt = wh + 2 * v3;
            oacc[v3] = (f32x4){0.f, 0.f, 0.f, 0.f};
            if (vt < NVT) {
#pragma unroll
                for (int ks = 0; ks < 4; ++ks) oacc[v3] = __builtin_amdgcn_mfma_f32_16x16x32_bf16(aq[ks], ldfrag(sS, vt * 16, ks, LQ, fr, fq), oacc[v3], 0, 0, 0);
                oacc[v3] *= erow;
            }
        }
        __syncthreads();
        {
            bf16x8 ap[2];
#pragma unroll
            for (int ks = 0; ks < 2; ++ks) ap[ks] = ldfrag(sP, rt * 16, ks, LT, fr, fq);
#pragma unroll
            for (int v3 = 0; v3 < 3; ++v3) {
                const int vt = wh + 2 * v3;
                if (vt < NVT) {
#pragma unroll
                    for (int ks = 0; ks < 2; ++ks) oacc[v3] = __builtin_amdgcn_mfma_f32_16x16x32_bf16(ap[ks], ldfrag_tr(sV, ks * 32 + fq * 8, vt * 16, PV, fr), oacc[v3], 0, 0, 0);
                    const int vv = vt * 16 + fr;
#pragma unroll
                    for (int r = 0; r < 4; ++r) { const int ii = rt * 16 + fq * 4 + r;
                        if (vv < VW) sout[ii * VW + vv] = oacc[v3][r]; else if (vv == VW) sden[ii] = oacc[v3][r]; }
                }
            }
        }
        {
            const float sc = __expf(cend);
            bf16x8 ak[2];
#pragma unroll
            for (int ks = 0; ks < 2; ++ks) ak[ks] = ldfrag_tr(sK, ks * 32 + fq * 8, wid * 16, LQ, fr);
#pragma unroll
            for (int vt = 0; vt < NVT; ++vt) {
                Sacc[vt] *= sc;
#pragma unroll
                for (int ks = 0; ks < 2; ++ks) Sacc[vt] = __builtin_amdgcn_mfma_f32_16x16x32_bf16(ak[ks], ldfrag_tr(sVw, ks * 32 + fq * 8, vt * 16, PV, fr), Sacc[vt], 0, 0, 0);
                u32x2 w2; w2.x = pack2(Sacc[vt][0], Sacc[vt][1]); w2.y = pack2(Sacc[vt][2], Sacc[vt][3]);
                *(u32x2*)(sS + (vt * 16 + fr) * LQ + wid * 16 + fq * 4) = w2;
            }
        }
        __syncthreads();
        { const int i = tid_ >> 3, c8 = (tid_ & 7) * 8, pi = c0 + i, t = d ? (len - 1 - pi) : pi; float o[8]; ldf8(sout + i * 64 + c8, o);
          if (IS_SSD) st8(yd + (size_t)(rowbase + t) * DM + 512 + h * 64 + c8, o);
          else if (VW == 64) { st8(yd + (size_t)(rowbase + t) * DM + 1024 + h * 256 + vq * 64 + c8, o);
                 if (vq == 0 && tid_ < 64) { const int pj = c0 + tid_, tj = d ? (len - 1 - pj) : pj; den[(size_t)(rowbase + tj) * 4 + h] = sden[tid_]; } }
          else { if (tid_ < 256) { const int i2 = tid_ >> 2, c82 = (tid_ & 3) * 8, pi2 = c0 + i2, t2 = d ? (len - 1 - pi2) : pi2; float o2[8]; ldf8(sout + i2 * 32 + c82, o2);
                     st8(yd + (size_t)(rowbase + t2) * DM + 1024 + h * 256 + vq * 32 + c82, o2); }
                 if (vq == 0 && tid_ < 64) { const int pj = c0 + tid_, tj = d ? (len - 1 - pj) : pj; den[(size_t)(rowbase + tj) * 4 + h] = sden[tid_]; } } }
    }
}

__device__ void gdn_qk_prepass(CP& p) {
    OPQ_IDS;
    const int lane = tid_ & 63, wid = tid_ >> 6;
    const bf16_t* proj = (const bf16_t*)(p.ws + WS_BIG); bf16_t* qk = (bf16_t*)(p.ws + WS_ACT);
    for (int row = bid_ * 8 + wid; row < MTOT; row += gridDim.x * 8) {
        int t, len;
        if (row < MLAT) { t = row & (SEQ - 1); len = SEQ; } else { t = (row - MLAT) & (CTXL - 1); len = CTXL; }
        const bf16_t* pr = proj + (size_t)row * NO_MAIN;
#pragma unroll
        for (int ps = 0; ps < 4; ++ps) { const int c = ps * 512 + lane * 8;
            float x0[8], xm[8], xp[8], w0[8], w1[8], w2[8], o[8];
            ld8(pr + c, x0);
            if (t > 0) ld8(pr - NO_MAIN + c, xm); else { for (int q = 0; q < 8; ++q) xm[q] = 0.f; }
            if (t < len - 1) ld8(pr + NO_MAIN + c, xp); else { for (int q = 0; q < 8; ++q) xp[q] = 0.f; }
            ldf8(p.in[31] + c, w0); ldf8(p.in[31] + 3072 + c, w1); ldf8(p.in[31] + 6144 + c, w2);
            float ss = 0.f;
#pragma unroll
            for (int q = 0; q < 8; ++q) { o[q] = siluf_(w0[q] * xm[q] + w1[q] * x0[q] + w2[q] * xp[q]); ss += o[q] * o[q]; }
            ss = red16(ss);
            const float rs = rsqrtf(ss + 1e-6f) * (ps < 2 ? 0.08838834764831845f : 1.f);
#pragma unroll
            for (int q = 0; q < 8; ++q) o[q] *= rs;
            st8(qk + (size_t)row * 2048 + c, o); }
    }
}
struct GdnRaw { u32x2 qk[8]; u32x2 v0, vm, vp; };
__device__ __forceinline__ void gdn_load(GdnRaw& r, const bf16_t* proj, const bf16_t* qkbuf, int rowbase, int len, int c0, int d, int h, int vqr, int tid_) {
    asm volatile("" : "+v"(tid_));
#pragma unroll
    for (int k = 0; k < 8; ++k) { const int it = tid_ + k * NTHR, i = it >> 6, ch = (it & 63) * 4, pi = c0 + i, t = d ? (len - 1 - pi) : pi;
        r.qk[k] = *(const u32x2*)(qkbuf + (size_t)(rowbase + t) * 2048 + (ch < 128 ? (h * 128 + ch) : (1024 + h * 128 + (ch - 128)))); }
    { const int i = tid_ >> 3, ch = (tid_ & 7) * 4, pi = c0 + i, t = d ? (len - 1 - pi) : pi;
      const bf16_t* pp = proj + (size_t)(rowbase + t) * NO_MAIN + 2048 + h * 128 + vqr * 32 + ch;
      r.v0 = *(const u32x2*)pp; r.vm = *(const u32x2*)(pp - (t > 0 ? NO_MAIN : 0)); r.vp = *(const u32x2*)(pp + (t < len - 1 ? NO_MAIN : 0)); }
}
__device__ void scan_gdn256(CP& p, unsigned char* shm, int id) {
    OPQ_IDS;
    const int tid = tid_, lane = tid & 63, wid = tid >> 6;
    const int b = id >> 6, rem = id & 63, h = rem >> 3, d = (rem >> 2) & 1, vqr = rem & 3;
    constexpr int NCH = 288, RS = 292;
    float* srow = (float*)shm;
    float* scw = srow + 64 * RS;
    float* scb = scw + 3 * NCH;
    float* sout = scb + NCH;
    const bf16_t* proj = (const bf16_t*)(p.ws + WS_BIG);
    const float* gates = (const float*)(p.ws + WS_GATES);
    bf16_t* yd = (bf16_t*)(p.ws + WS_BIG + BIG_PROJ) + (size_t)d * MTOT * DM;
    auto colmap = [=](int ch) { return ch < 128 ? (h * 128 + ch) : (ch < 256 ? (1024 + h * 128 + (ch - 128)) : (2048 + h * 128 + vqr * 32 + (ch - 256))); };
    for (int e = tid; e < NCH; e += NTHR) { const int cc = colmap(e);
        scw[e] = p.in[31][cc]; scw[NCH + e] = p.in[31][3072 + cc]; scw[2 * NCH + e] = p.in[31][2 * 3072 + cc]; scb[e] = 0.f; }
    const float dtb = p.in[32][d * 8 + h], aexp = -expf(p.in[33][d * 8 + h]);
    const int ks = tid & 15, col = tid >> 4;
    f32x2 S2[4];
#pragma unroll
    for (int jx = 0; jx < 4; ++jx) S2[jx] = (f32x2){0.f, 0.f};
    __syncthreads();
    GdnRaw raw; float graw0 = 0.f, graw1 = 0.f;
    const bf16_t* qkbuf = (const bf16_t*)(p.ws + WS_ACT);
    { int len, rowbase, c0; chunk_pos(0, b, len, rowbase, c0); gdn_load(raw, proj, qkbuf, rowbase, len, c0, d, h, vqr, tid_);
      if (tid_ < 64) { const int pi = c0 + tid_, t = d ? (len - 1 - pi) : pi; const float* gp = gates + (size_t)(rowbase + t) * 64; graw0 = gp[d * 8 + h]; graw1 = gp[16 + d * 8 + h]; } }
    for (int cidx = 0; cidx < 68; ++cidx) {
        int len, rowbase, c0; chunk_pos(cidx, b, len, rowbase, c0);
        {
            int tl = tid_; asm volatile("" : "+v"(tl));
#pragma unroll
            for (int k = 0; k < 8; ++k) { const int it = tl + k * NTHR, i = it >> 6, ch = (it & 63) * 4; const u32x2 x = raw.qk[k];
                *(f32x4*)(srow + i * RS + ch) = (f32x4){lo16(x.x), hi16(x.x), lo16(x.y), hi16(x.y)}; }
            { const int i = tl >> 3, ch = 256 + (tl & 7) * 4, pi = c0 + i, t = d ? (len - 1 - pi) : pi;
              const u32x2 x0 = raw.v0, xm = raw.vm, xp = raw.vp;
              const f32x4 f0 = (f32x4){lo16(x0.x), hi16(x0.x), lo16(x0.y), hi16(x0.y)};
              const f32x4 fm = (t > 0) ? (f32x4){lo16(xm.x), hi16(xm.x), lo16(xm.y), hi16(xm.y)} : (f32x4){0.f, 0.f, 0.f, 0.f};
              const f32x4 fp = (t < len - 1) ? (f32x4){lo16(xp.x), hi16(xp.x), lo16(xp.y), hi16(xp.y)} : (f32x4){0.f, 0.f, 0.f, 0.f};
              f32x4 v = *(const f32x4*)(scw + ch) * fm + *(const f32x4*)(scw + NCH + ch) * f0 + *(const f32x4*)(scw + 2 * NCH + ch) * fp;
              v[0] = siluf_(v[0]); v[1] = siluf_(v[1]); v[2] = siluf_(v[2]); v[3] = siluf_(v[3]);
              *(f32x4*)(srow + i * RS + ch) = v; }
        }
        if (tid_ < 64) { srow[tid_ * RS + 288] = expf(aexp * softplusf_(graw1 + dtb)); srow[tid_ * RS + 289] = sigmoidf_(graw0); }
        __syncthreads();
        if (cidx + 1 < 68) { int len2, rowbase2, c02; chunk_pos(cidx + 1, b, len2, rowbase2, c02); gdn_load(raw, proj, qkbuf, rowbase2, len2, c02, d, h, vqr, tid_);
            if (tid_ < 64) { const int pi = c02 + tid_, t = d ? (len2 - 1 - pi) : pi; const float* gp = gates + (size_t)(rowbase2 + t) * 64; graw0 = gp[d * 8 + h]; graw1 = gp[16 + d * 8 + h]; } }
        {
            float* r0 = srow + (2 * (wid * 4 + (lane >> 4))) * RS; const float* r1 = r0 + RS; const int o8 = (lane & 15) * 8;
            const f32x4 k0a = *(const f32x4*)(r0 + 128 + o8), k0b = *(const f32x4*)(r0 + 132 + o8), k1a = *(const f32x4*)(r1 + 128 + o8), k1b = *(const f32x4*)(r1 + 132 + o8), q0a = *(const f32x4*)(r0 + o8), q0b = *(const f32x4*)(r0 + 4 + o8);
            float gk = k1a[0] * k0a[0] + k1a[1] * k0a[1] + k1a[2] * k0a[2] + k1a[3] * k0a[3] + k1b[0] * k0b[0] + k1b[1] * k0b[1] + k1b[2] * k0b[2] + k1b[3] * k0b[3];
            float rq2 = q0a[0] * k0a[0] + q0a[1] * k0a[1] + q0a[2] * k0a[2] + q0a[3] * k0a[3] + q0b[0] * k0b[0] + q0b[1] * k0b[1] + q0b[2] * k0b[2] + q0b[3] * k0b[3];
            gk = red16(gk); rq2 = red16(rq2);
            if ((lane & 15) == 0) { r0[290] = gk; r0[291] = rq2; }
        }
        __syncthreads();
        {
            const float* rk_p = srow + ks * 8;
            const float* rv_p = srow + 256 + col;
            float* so_p = sout + col;
            for (int m = 0; m < 32; ++m) {
                const f32x4 q0a = *(const f32x4*)(rk_p), q0b = *(const f32x4*)(rk_p + 4), k0a = *(const f32x4*)(rk_p + 128), k0b = *(const f32x4*)(rk_p + 132);
                const f32x4 q1a = *(const f32x4*)(rk_p + RS), q1b = *(const f32x4*)(rk_p + RS + 4), k1a = *(const f32x4*)(rk_p + RS + 128), k1b = *(const f32x4*)(rk_p + RS + 132);
                const f32x4 t0 = *(const f32x4*)(srow + (2 * m) * RS + 288);
                const float2 t1 = *(const float2*)(srow + (2 * m + 1) * RS + 288);
                const float v0 = rv_p[0], v1 = rv_p[RS];
                const f32x2 k0[4] = {{k0a[0], k0a[1]}, {k0a[2], k0a[3]}, {k0b[0], k0b[1]}, {k0b[2], k0b[3]}};
                const f32x2 k1[4] = {{k1a[0], k1a[1]}, {k1a[2], k1a[3]}, {k1b[0], k1b[1]}, {k1b[2], k1b[3]}};
                const f32x2 q0[4] = {{q0a[0], q0a[1]}, {q0a[2], q0a[3]}, {q0b[0], q0b[1]}, {q0b[2], q0b[3]}};
                const f32x2 q1[4] = {{q1a[0], q1a[1]}, {q1a[2], q1a[3]}, {q1b[0], q1b[1]}, {q1b[2], q1b[3]}};
                f32x2 d2 = k0[0] * S2[0], e2 = k1[0] * S2[0], f2 = q0[0] * S2[0];
#pragma unroll
                for (int e = 1; e < 4; ++e) { d2 = k0[e] * S2[e] + d2; e2 = k1[e] * S2[e] + e2; f2 = q0[e] * S2[e] + f2; }
                float dd = d2[0] + d2[1], ee = e2[0] + e2[1], ff = f2[0] + f2[1];
                dd += dppmov<0xB1>(dd); ee += dppmov<0xB1>(ee); ff += dppmov<0xB1>(ff);
                dd += dppmov<0x4E>(dd); ee += dppmov<0x4E>(ee); ff += dppmov<0x4E>(ff);
                dd += dppmov<0x141>(dd); ee += dppmov<0x141>(ee); ff += dppmov<0x141>(ff);
                dd += dppmov<0x140>(dd); ee += dppmov<0x140>(ee); ff += dppmov<0x140>(ff);
                const float w0 = t0[1] * (v0 - t0[0] * dd);
                const float o0 = t0[0] * ff + t0[3] * w0;
                const float d1 = t0[0] * ee + t0[2] * w0;
                const float w1 = t1.y * (v1 - t1.x * d1);
                const float c0s = t1.x * t0[0], c1s = t1.x * w0;
#pragma unroll
                for (int e = 0; e < 4; ++e) S2[e] = S2[e] * c0s + k0[e] * c1s + k1[e] * w1;
                f32x2 o2 = q1[0] * S2[0];
#pragma unroll
                for (int e = 1; e < 4; ++e) o2 = q1[e] * S2[e] + o2;
                const float o1 = red16(o2[0] + o2[1]);
                if (ks == 0) { so_p[(2 * m) * 32] = o0; so_p[(2 * m + 1) * 32] = o1; }
                rk_p += 2 * RS; rv_p += 2 * RS;
            }
        }
        __syncthreads();
        if (tid_ < 256) { const int i = tid_ >> 2, c8 = (tid_ & 3) * 8, pi = c0 + i, t = d ? (len - 1 - pi) : pi; float o[8]; ldf8(sout + i * 32 + c8, o);
            st8(yd + (size_t)(rowbase + t) * DM + h * 128 + vqr * 32 + c8, o); }
    }
}

__device__ void scan_s5v2(CP& p, unsigned char* shm, int s) {
    OPQ_IDS;
    const int lane = tid_ & 63, wid = tid_ >> 6, fr = lane & 15, fq = lane >> 4;
    const int b = s >> 6, rem = s & 63, g = rem >> 1, d = rem & 1, dg = d * 32 + g;
    constexpr int LU = 40;
    bf16_t* sU = (bf16_t*)shm;
    bf16_t* sBb = sU + 64 * LU;
    bf16_t* sX = sBb + 128 * LU;
    bf16_t* sCm = sX + 64 * LQ;
    float* sBU = (float*)(sCm + 16 * LQ);
    const bf16_t* proj = (const bf16_t*)(p.ws + WS_BIG);
    bf16_t* yd = (bf16_t*)(p.ws + WS_BIG + BIG_PROJ) + (size_t)d * MTOT * DM;
    float lbr = 0.f, lis = 0.f;
    if (tid_ < 128) {
        const int j = tid_, st = j >> 1, part = j & 1;
        const float lr = p.in[14][dg * 64 + st], li = p.in[15][dg * 64 + st], step = expf(p.in[16][dg]);
        const float ea = lr * step, eb = li * step, mag = expf(ea), cb = cosf(eb), sb = sinf(eb), shb = sinf(0.5f * eb);
        lbr = mag * cb; const float lbi = mag * sb;
        const float nr = expm1f(ea) * cb - 2.f * shb * shb, ni = lbi;
        const float den = lr * lr + li * li;
        const float qr = (nr * lr + ni * li) / den, qi = (ni * lr - nr * li) / den;
        lis = part ? lbi : -lbi;
#pragma unroll
        for (int hh = 0; hh < 16; ++hh) { const float br = p.in[17][(size_t)(dg * 64 + st) * 16 + hh], bi = p.in[18][(size_t)(dg * 64 + st) * 16 + hh];
            const float v = part ? (qr * bi + qi * br) : (qr * br - qi * bi);
            const bf16_t hi = f2bf(v); const bf16_t lo = f2bf(v - bf2f(hi));
            sBb[j * LU + hh] = hi; sBb[j * LU + 16 + hh] = lo;
            sCm[hh * LQ + j] = f2bf(part ? -p.in[20][(size_t)(dg * 16 + hh) * 64 + st] : p.in[19][(size_t)(dg * 16 + hh) * 64 + st]); }
    }
    float x = 0.f;
    u32x2 uraw = (u32x2){0u, 0u};
    if (tid_ < 256) { int len, rowbase, c0; chunk_pos(0, b, len, rowbase, c0); const int i = tid_ >> 2, hq = tid_ & 3, pi = c0 + i, t = d ? (len - 1 - pi) : pi;
        uraw = *(const u32x2*)(proj + (size_t)(rowbase + t) * NE_MAIN + g * 16 + hq * 4); }
    __syncthreads();
    for (int cidx = 0; cidx < 68; ++cidx) {
        int len, rowbase, c0; chunk_pos(cidx, b, len, rowbase, c0);
        if (tid_ < 256) { const int i = tid_ >> 2, hq = tid_ & 3; *(u32x2*)(sU + i * LU + hq * 4) = uraw; *(u32x2*)(sU + i * LU + 16 + hq * 4) = uraw; }
        __syncthreads();
#pragma unroll
        for (int q = 0; q < 4; ++q) { const int tile = wid * 4 + q, tt = tile >> 3, jt = tile & 7;
            f32x4 acc = (f32x4){0.f, 0.f, 0.f, 0.f};
            acc = __builtin_amdgcn_mfma_f32_16x16x32_bf16(ldfrag(sU, tt * 16, 0, LU, fr, fq), ldfrag(sBb, jt * 16, 0, LU, fr, fq), acc, 0, 0, 0);
#pragma unroll
            for (int r = 0; r < 4; ++r) sBU[(tt * 16 + fq * 4 + r) * 128 + jt * 16 + fr] = acc[r]; }
        __syncthreads();
        if (cidx + 1 < 68 && tid_ < 256) { int len2, rowbase2, c02; chunk_pos(cidx + 1, b, len2, rowbase2, c02); const int i = tid_ >> 2, hq = tid_ & 3, pi = c02 + i, t = d ? (len2 - 1 - pi) : pi;
            uraw = *(const u32x2*)(proj + (size_t)(rowbase2 + t) * NE_MAIN + g * 16 + hq * 4); }
        if (tid_ < 128) {
            float bun = sBU[tid_];
            for (int i = 0; i < 64; ++i) {
                const float bu = bun; if (i < 63) bun = sBU[(i + 1) * 128 + tid_];
                const float xp = dppmov<0xB1>(x);
                x = lbr * x + lis * xp + bu;
                sX[i * LQ + tid_] = f2bf(x);
            }
        }
        __syncthreads();
        if (wid < 4) {
            f32x4 acc = (f32x4){0.f, 0.f, 0.f, 0.f};
#pragma unroll
            for (int ks = 0; ks < 4; ++ks) acc = __builtin_amdgcn_mfma_f32_16x16x32_bf16(ldfrag(sX, wid * 16, ks, LQ, fr, fq), ldfrag(sCm, 0, ks, LQ, fr, fq), acc, 0, 0, 0);
#pragma unroll
            for (int r = 0; r < 4; ++r) { const int pi = c0 + wid * 16 + fq * 4 + r, t = d ? (len - 1 - pi) : pi;
                yd[(size_t)(rowbase + t) * DM + g * 16 + fr] = f2bf(acc[r]); }
        }
    }
}

__device__ void scan_s5v3(CP& p, unsigned char* shm, int id2) {
    OPQ_IDS;
    const int lane = tid_ & 63, wid = tid_ >> 6, fr = lane & 15, fq = lane >> 4;
    const int sl = wid >> 1, wp = wid & 1, j = tid_ & 127, st = j >> 1, part = j & 1;
    const int s = id2 * 4 + sl, b = s >> 6, rem = s & 63, g = rem >> 1, d = rem & 1, dg = d * 32 + g;
    constexpr int LU = 40, SCAN_BYTES = 2560 + 8704 + 16384;
    unsigned char* sb = shm + sl * SCAN_BYTES;
    bf16_t* sU = (bf16_t*)sb;
    bf16_t* sX = (bf16_t*)(sb + 2560);
    float* sBU = (float*)(sb + 2560 + 8704);
    const bf16_t* proj = (const bf16_t*)(p.ws + WS_BIG);
    bf16_t* yd = (bf16_t*)(p.ws + WS_BIG + BIG_PROJ) + (size_t)d * MTOT * DM;
    float lbr, lis;
    bf16x8 bfrag[4], cfrag[4];
    {
        bf16_t* tBb = (bf16_t*)shm + sl * (128 * LU);
        bf16_t* tCm = (bf16_t*)shm + 4 * (128 * LU) + sl * (16 * LQ);
        const float lr = p.in[14][dg * 64 + st], li = p.in[15][dg * 64 + st], step = expf(p.in[16][dg]);
        const float ea = lr * step, eb = li * step, mag = expf(ea), cb = cosf(eb), sbn = sinf(eb), shb = sinf(0.5f * eb);
        lbr = mag * cb; const float lbi = mag * sbn;
        const float nr = expm1f(ea) * cb - 2.f * shb * shb, ni = lbi;
        const float den = lr * lr + li * li;
        const float qr = (nr * lr + ni * li) / den, qi = (ni * lr - nr * li) / den;
        lis = part ? lbi : -lbi;
#pragma unroll
        for (int hh = 0; hh < 16; ++hh) { const float br = p.in[17][(size_t)(dg * 64 + st) * 16 + hh], bi = p.in[18][(size_t)(dg * 64 + st) * 16 + hh];
            const float v = part ? (qr * bi + qi * br) : (qr * br - qi * bi);
            const bf16_t hi = f2bf(v); const bf16_t lo = f2bf(v - bf2f(hi));
            tBb[j * LU + hh] = hi; tBb[j * LU + 16 + hh] = lo;
            tCm[hh * LQ + j] = f2bf(part ? -p.in[20][(size_t)(dg * 16 + hh) * 64 + st] : p.in[19][(size_t)(dg * 16 + hh) * 64 + st]); }
        __syncthreads();
#pragma unroll
        for (int q = 0; q < 4; ++q) { bfrag[q] = ldfrag(tBb, (wp * 4 + q) * 16, 0, LU, fr, fq); cfrag[q] = ldfrag(tCm, 0, q, LQ, fr, fq); }
        __syncthreads();
    }
    float x = 0.f;
    u32x2 uraw;
    { const int i = j >> 2, hq = j & 3, t = d ? (CTXL - 1 - i) : i;
      uraw = *(const u32x2*)(proj + (size_t)(MLAT + b * CTXL + t) * NE_MAIN + g * 16 + hq * 4); }
    for (int cidx = 0; cidx < 136; ++cidx) {
        int len, rowbase, c0;
        if (cidx < 8) { len = CTXL; rowbase = MLAT + b * CTXL; c0 = cidx * 32; } else { len = SEQ; rowbase = b * SEQ; c0 = (cidx - 8) * 32; }
        { const int i = j >> 2, hq = j & 3; *(u32x2*)(sU + i * LU + hq * 4) = uraw; *(u32x2*)(sU + i * LU + 16 + hq * 4) = uraw; }
        __syncthreads();
#pragma unroll
        for (int tt = 0; tt < 2; ++tt) { const bf16x8 au = ldfrag(sU, tt * 16, 0, LU, fr, fq);
#pragma unroll
            for (int q = 0; q < 4; ++q) { f32x4 acc = (f32x4){0.f, 0.f, 0.f, 0.f};
                acc = __builtin_amdgcn_mfma_f32_16x16x32_bf16(au, bfrag[q], acc, 0, 0, 0);
#pragma unroll
                for (int r = 0; r < 4; ++r) sBU[(tt * 16 + fq * 4 + r) * 128 + (wp * 4 + q) * 16 + fr] = acc[r]; } }
        __syncthreads();
        if (cidx + 1 < 136) { const int cn = cidx + 1; int len2, rowbase2, c02;
            if (cn < 8) { len2 = CTXL; rowbase2 = MLAT + b * CTXL; c02 = cn * 32; } else { len2 = SEQ; rowbase2 = b * SEQ; c02 = (cn - 8) * 32; }
            const int i = j >> 2, hq = j & 3, pi = c02 + i, t = d ? (len2 - 1 - pi) : pi;
            uraw = *(const u32x2*)(proj + (size_t)(rowbase2 + t) * NE_MAIN + g * 16 + hq * 4); }
        {
            float bun = sBU[j];
            for (int i = 0; i < 32; ++i) {
                const float bu = bun; if (i < 31) bun = sBU[(i + 1) * 128 + j];
                const float xp = dppmov<0xB1>(x);
                x = lbr * x + lis * xp + bu;
                sX[i * LQ + j] = f2bf(x);
            }
        }
        __syncthreads();
        {
            f32x4 acc = (f32x4){0.f, 0.f, 0.f, 0.f};
#pragma unroll
            for (int ks = 0; ks < 4; ++ks) acc = __builtin_amdgcn_mfma_f32_16x16x32_bf16(ldfrag(sX, wp * 16, ks, LQ, fr, fq), cfrag[ks], acc, 0, 0, 0);
#pragma unroll
            for (int r = 0; r < 4; ++r) { const int pi = c0 + wp * 16 + fq * 4 + r, t = d ? (len - 1 - pi) : pi;
                yd[(size_t)(rowbase + t) * DM + g * 16 + fr] = f2bf(acc[r]); }
        }
    }
}

__device__ void phase_post_even(CP& p) {
    OPQ_IDS;
    const int lane = tid_ & 63, wid = tid_ >> 6;
    const bf16_t* proj = (const bf16_t*)(p.ws + WS_BIG);
    const bf16_t* yd0 = (const bf16_t*)(p.ws + WS_BIG + BIG_PROJ); const bf16_t* yd1 = yd0 + (size_t)MTOT * DM;
    bf16_t* ybuf = (bf16_t*)(p.ws + WS_YBUF); bf16_t* ys5 = (bf16_t*)(p.ws + WS_YS5);
    for (int row = bid_ * 8 + wid; row < MTOT; row += gridDim.x * 8) {
        int t, len;
        if (row < MLAT) { t = row & (SEQ - 1); len = SEQ; } else { t = (row - MLAT) & (CTXL - 1); len = CTXL; }
        const bf16_t* pr = proj + (size_t)row * NE_MAIN;
        {
            const int c = lane * 8; float u[8], a[8], bq[8], dd[8], o[8];
            ld8(pr + c, u); ld8(yd0 + (size_t)row * DM + c, a); ld8(yd1 + (size_t)row * DM + c, bq); ldf8(p.in[21] + c, dd);
#pragma unroll
            for (int q = 0; q < 8; ++q) o[q] = gelu_tanh(dd[q] * u[q] + a[q] + bq[q]);
            st8(ys5 + (size_t)row * 512 + c, o);
        }
        for (int grp = 0; grp < 4; ++grp) {
            const bool act = lane < 48; const int ch = grp * 384 + (act ? lane : 0) * 8;
            float o[8]; float ss = 0.f;
            if (act) {
                float xm[8], x0[8], xp[8], a[8], bq[8], z[8], w0[8], w1[8], w2[8], cbv[8];
                ld8(pr + 2048 + ch, x0);
                if (t > 0) ld8(pr - NE_MAIN + 2048 + ch, xm); else { for (int q = 0; q < 8; ++q) xm[q] = 0.f; }
                if (t < len - 1) ld8(pr + NE_MAIN + 2048 + ch, xp); else { for (int q = 0; q < 8; ++q) xp[q] = 0.f; }
                ldf8(p.in[23] + ch, w0); ldf8(p.in[23] + 2560 + ch, w1); ldf8(p.in[23] + 5120 + ch, w2); ldf8(p.in[24] + ch, cbv);
                ld8(yd0 + (size_t)row * DM + 512 + ch, a); ld8(yd1 + (size_t)row * DM + 512 + ch, bq); ld8(pr + 512 + ch, z);
                const float dsk = p.in[27][ch >> 6];
#pragma unroll
                for (int q = 0; q < 8; ++q) { const float xs = siluf_(cbv[q] + w0[q] * xm[q] + w1[q] * x0[q] + w2[q] * xp[q]);
                    const float y = (a[q] + bq[q] + dsk * xs) * siluf_(z[q]); o[q] = y; ss += y * y; }
            }
            ss = red64(ss);
            const float rs = rsqrtf(ss * (1.f / 384.f) + 1e-6f);
            if (act) { float nwv[8]; ldf8(p.in[28] + ch, nwv);
#pragma unroll
                for (int q = 0; q < 8; ++q) o[q] = o[q] * rs * nwv[q];
                st8(ybuf + (size_t)row * DM + 512 + ch, o); }
        }
    }
}

__device__ void phase_post_odd(CP& p) {
    OPQ_IDS;
    const int lane = tid_ & 63, wid = tid_ >> 6;
    const bf16_t* proj = (const bf16_t*)(p.ws + WS_BIG);
    const bf16_t* yd0 = (const bf16_t*)(p.ws + WS_BIG + BIG_PROJ); const bf16_t* yd1 = yd0 + (size_t)MTOT * DM;
    const float* den0 = (const float*)(p.ws + WS_DEN); const float* den1 = den0 + (size_t)MTOT * 4;
    bf16_t* ybuf = (bf16_t*)(p.ws + WS_YBUF);
    for (int row = bid_ * 8 + wid; row < MTOT; row += gridDim.x * 8) {
        const bf16_t* pr = proj + (size_t)row * NO_MAIN;
        for (int half = 0; half < 2; ++half) {
            const int c = half * 512 + lane * 8; float a[8], bq[8], z[8], nwv[8], o[8]; float ss = 0.f;
            ld8(yd0 + (size_t)row * DM + c, a); ld8(yd1 + (size_t)row * DM + c, bq); ld8(pr + 3072 + c, z); ldf8(p.in[34] + (c & 127), nwv);
#pragma unroll
            for (int q = 0; q < 8; ++q) { o[q] = a[q] + bq[q]; ss += o[q] * o[q]; }
            ss = red16(ss);
            const float rs = rsqrtf(ss * (1.f / 128.f) + 1e-6f);
#pragma unroll
            for (int q = 0; q < 8; ++q) o[q] = o[q] * rs * nwv[q] * siluf_(z[q]);
            st8(ybuf + (size_t)row * DM + c, o);
        }
        for (int half = 0; half < 2; ++half) {
            const int c = half * 512 + lane * 8, hd = c >> 8; float a[8], bq[8], om[8], nwv[8], o[8]; float ss = 0.f;
            ld8(yd0 + (size_t)row * DM + 1024 + c, a); ld8(yd1 + (size_t)row * DM + 1024 + c, bq); ld8(pr + 6144 + c, om); ldf8(p.in[37] + c, nwv);
            const float i0 = 1.f / fmaxf(fabsf(den0[(size_t)row * 4 + hd]), 1.f), i1 = 1.f / fmaxf(fabsf(den1[(size_t)row * 4 + hd]), 1.f);
#pragma unroll
            for (int q = 0; q < 8; ++q) { o[q] = a[q] * i0 + bq[q] * i1; ss += o[q] * o[q]; }
            ss = red32(ss);
            const float rs = rsqrtf(ss * (1.f / 256.f) + 1e-6f);
#pragma unroll
            for (int q = 0; q < 8; ++q) o[q] = o[q] * rs * nwv[q] * sigmoidf_(om[q]);
            st8(ybuf + (size_t)row * DM + 1024 + c, o);
        }
    }
}

#define XB_TMO      128
#define XB_XCNT(j)  (256  + 64 * (j))
#define XB_XSUB(j)  (1280 + 64 * (j))
#define XB_XGEN(j)  (2304 + 64 * (j))
#define XB_TOP      3328
#define XB_TOPGEN   3392
#define XCD_BAR_WORDS 3456
#define XB_SPIN_CAP (1u << 18)
__device__ __forceinline__ unsigned xb_ld(unsigned* p)              { return __hip_atomic_load(p, __ATOMIC_RELAXED, __HIP_MEMORY_SCOPE_AGENT); }
__device__ __forceinline__ unsigned xb_add(unsigned* p, unsigned v) { return __hip_atomic_fetch_add(p, v, __ATOMIC_RELAXED, __HIP_MEMORY_SCOPE_AGENT); }
__device__ __forceinline__ unsigned xb_xcc_id() { return (unsigned)__builtin_amdgcn_s_getreg((3 << 11) | 20) & 0xFu; }
#define XB_SPIN(cond, bar) do { unsigned _sp = 0; while (cond) { __builtin_amdgcn_s_sleep(1); \
    if ((++_sp & 255u) == 0u) { if (xb_ld(&(bar)[XB_TMO])) break; if (_sp > XB_SPIN_CAP) { atomicAdd(&(bar)[XB_TMO], 1u); break; } } } } while (0)
struct XcdBarrier { unsigned* bar; unsigned x; volatile LAS unsigned* st; };
__device__ __forceinline__ void xcd_barrier_complete(unsigned* bar, unsigned x, unsigned& nloc, unsigned& nx) {
    const unsigned G = gridDim.x * gridDim.y * gridDim.z;
    unsigned sum, cnt, mine, sp = 0u;
    for (;;) {
        sum = 0u; cnt = 0u; mine = 0u;
#pragma unroll
        for (unsigned j = 0; j < 16; ++j) { const unsigned c = xb_ld(&bar[XB_XCNT(j)]); sum += c; cnt += (c > 0u) ? 1u : 0u; mine = (j == x) ? c : mine; }
        if (sum == G) break;
        __builtin_amdgcn_s_sleep(1);
        if ((++sp & 255u) == 0u) { if (xb_ld(&bar[XB_TMO])) break; if (sp > XB_SPIN_CAP) { atomicAdd(&bar[XB_TMO], 1u); break; } }
    }
    nloc = mine > 0u ? mine : 1u; nx = cnt > 0u ? cnt : 1u;
}
__device__ __forceinline__ void xcd_barrier(const XcdBarrier& b) {
    asm volatile("s_waitcnt vmcnt(0)" ::: "memory");
    __syncthreads();
    if (threadIdx.x == 0) {
        unsigned* bar = b.bar;
        __builtin_amdgcn_s_waitcnt(0);
        unsigned nloc = b.st[0], nx = b.st[1];
        if (nloc == 0u) { xcd_barrier_complete(bar, b.x, nloc, nx); b.st[0] = nloc; b.st[1] = nx; }
        const unsigned old = xb_add(&bar[XB_XSUB(b.x)], 1u);
        const unsigned gen = old / nloc;
        if (old + 1u == (gen + 1u) * nloc) {
            __builtin_amdgcn_fence(__ATOMIC_RELEASE, "agent");
            asm volatile("s_waitcnt vmcnt(0)" ::: "memory");
            const unsigned og = xb_add(&bar[XB_TOP], 1u);
            const unsigned tg = og / nx;
            if (og + 1u == (tg + 1u) * nx) xb_add(&bar[XB_TOPGEN], 1u);
            else XB_SPIN(xb_ld(&bar[XB_TOPGEN]) == tg, bar);
            __builtin_amdgcn_fence(__ATOMIC_ACQUIRE, "agent");
            xb_add(&bar[XB_XGEN(b.x)], 1u);
            asm volatile("s_waitcnt vmcnt(0)" ::: "memory");
        } else {
            XB_SPIN(xb_ld(&bar[XB_XGEN(b.x)]) == gen, bar);
            __builtin_amdgcn_fence(__ATOMIC_ACQUIRE, "agent");
            asm volatile("s_waitcnt vmcnt(0)" ::: "memory");
        }
    }
    __syncthreads();
}

__global__ void __launch_bounds__(NTHR, 2) fwd_megakernel(Params p_unused) {
    extern __shared__ __attribute__((aligned(16))) unsigned char shm[];
    cg::grid_group grid = cg::this_grid();
    volatile LAS unsigned* xb_st = (volatile LAS unsigned*)((LAS unsigned char*)shm + (LDS_BYTES - 16));
    if (threadIdx.x == 0) { xb_st[0] = 0u; xb_st[1] = 0u; }
    {
        CP* kp0 = (CP*)__builtin_amdgcn_kernarg_segment_ptr();
        unsigned* bw = (unsigned*)(kp0->ws + WS_BARW);
        if (blockIdx.x == 0) for (int e = threadIdx.x; e < XCD_BAR_WORDS; e += NTHR) bw[e] = 0u;
    }
    __syncthreads();
    for (int ph = 0; ph < 23; ++ph) {
        CP* kp = (CP*)__builtin_amdgcn_kernarg_segment_ptr(); asm volatile("" : "+s"(kp));
        CP& p = *kp;
        int bidk = blockIdx.x; asm volatile("" : "+s"(bidk));
        unsigned char* ws = p.ws;
        float* xc = (float*)(ws + WS_XC);
        bf16_t* act = (bf16_t*)(ws + WS_ACT);
        bf16_t* ybuf = (bf16_t*)(ws + WS_YBUF);
        bf16_t* big = (bf16_t*)(ws + WS_BIG);
        float* gates = (float*)(ws + WS_GATES);
        const float* modf = (const float*)(ws + WS_MODF);
        if (ph == 0) phase_prologue(p, shm);
        else if (ph == 1) phase_modreduce(p);
        else if (ph == 22) phase_final_norm(p);
        else {
            const int layer = (ph - 2) / 10, sub = (ph - 2) % 10;
            const bool even = (layer == 0);
            const int mres = even ? MTOT : MLAT;
            if (sub == 4 && !even) continue;
            if (sub == 0) phase_norm(p, layer, 0, MTOT, even);
            else if (sub == 6) phase_norm(p, layer, 1, mres, false);
            else if (sub == 1 || sub == 7) {
                const bool up = (sub == 7);
                const int nmain = up ? UPN : (even ? NE_MAIN : NO_MAIN), N = up ? UPN : (even ? NE : NO);
                const size_t wo = up ? (even ? WS_WUP0 : WS_WUP1) : (even ? WS_WINE : WS_WINO);
                pg8::EpiOut E{big, nmain, nmain / 256, gates};
                run_gemm(shm, act, DM, (const bf16_t*)(ws + wo), up ? mres : MTOT, N, DM, E);
            }
            else if (sub == 2) {
                if (even) { ssd_bc_prepass(p);
                            { XcdBarrier xb2; xb2.bar = (unsigned*)(ws + WS_BARW); xb2.x = xb_xcc_id(); xb2.st = xb_st; xcd_barrier(xb2); }
                            if (bidk < 192) scan_la<4, true, 64>(p, shm, bidk); else if (bidk < 256) scan_s5v3(p, shm, bidk - 192); }
                else      { gdn_qk_prepass(p);
                            { XcdBarrier xb2; xb2.bar = (unsigned*)(ws + WS_BARW); xb2.x = xb_xcc_id(); xb2.st = xb_st; xcd_barrier(xb2); }
                            if (bidk < 256) scan_gdn256(p, shm, bidk); __syncthreads(); if (bidk < 256) scan_la<3, false, 32>(p, shm, bidk); }
            }
            else if (sub == 3) { if (even) phase_post_even(p); else phase_post_odd(p); }
            else if (sub == 4) { pg8::EpiGlu E{(const bf16_t*)(ws + WS_YS5), ybuf}; run_gemm(shm, (const bf16_t*)(ws + WS_YS5), 512, (const bf16_t*)(ws + WS_WGLU), MTOT, 512, 512, E); }
            else if (sub == 5 || sub == 9) {
                const bool dn = (sub == 9);
                const bool first = even && !dn;
                pg8::EpiResid E{first ? p.in[0] : p.out, first ? p.in[2] : xc, p.out, xc, modf + (size_t)layer * 5 * MODN + (dn ? 5 : 2) * DM};
                const size_t wo = dn ? (even ? WS_WDN0 : WS_WDN1) : (even ? WS_WOUT0 : WS_WOUT1);
                run_gemm(shm, dn ? big + FFN : ybuf, dn ? UPN : DM, (const bf16_t*)(ws + wo), mres, DM, dn ? FFN : DM, E);
            }
            else if (sub == 8) phase_ffnconv(p, layer, mres);
        }
        if (ph == 0) { grid.sync(); if (threadIdx.x == 0) (void)xb_add(&((unsigned*)(ws + WS_BARW))[XB_XCNT(xb_xcc_id())], 1u); }
        else if (ph < 22) { XcdBarrier xb; xb.bar = (unsigned*)(ws + WS_BARW); xb.x = xb_xcc_id(); xb.st = xb_st; xcd_barrier(xb); }
    }
}

extern "C" void kernel_launch(void* const* d_in, const int* in_sizes, int n_in, void* d_out, int out_size, void* d_ws, size_t ws_size, hipStream_t stream) {
    static int grid_blocks = 0;
    if (grid_blocks == 0) {
        if (n_in != 38 || out_size != MLAT * DM || ws_size < WS_END) { fprintf(stderr, "kernel_launch: unexpected shapes: n_in %d out %d ws %zu (need %zu)\n", n_in, out_size, ws_size, (size_t)WS_END); grid_blocks = -1; return; }
        int dev = 0, cus = 0, per_cu = 0;
        hipGetDevice(&dev);
        hipDeviceGetAttribute(&cus, hipDeviceAttributeMultiprocessorCount, dev);
        if (hipFuncSetAttribute((const void*)fwd_megakernel, hipFuncAttributeMaxDynamicSharedMemorySize, LDS_BYTES) != hipSuccess) { fprintf(stderr, "kernel_launch: hipFuncSetAttribute failed\n"); grid_blocks = -1; return; }
        hipOccupancyMaxActiveBlocksPerMultiprocessor(&per_cu, (const void*)fwd_megakernel, NTHR, LDS_BYTES);
        if (per_cu < 1) { fprintf(stderr, "kernel_launch: occupancy query says %d blocks/CU\n", per_cu); per_cu = 1; }
        (void)hipGetLastError();
        grid_blocks = cus;
        if (grid_blocks < 256) fprintf(stderr, "kernel_launch: only %d CUs; scans need 256 workgroups\n", grid_blocks);
        if (grid_blocks > 256) grid_blocks = 256;
    }
    if (grid_blocks < 0) return;
    Params p{};
    for (int i = 0; i < 38; ++i) p.in[i] = (const float*)d_in[i];
    p.out = (float*)d_out; p.ws = (unsigned char*)d_ws;
    void* args[] = {&p};
    hipError_t e = hipLaunchCooperativeKernel((const void*)fwd_megakernel, dim3(grid_blocks), dim3(NTHR), args, LDS_BYTES, stream);
    if (e != hipSuccess) fprintf(stderr, "cooperative launch failed: %s (grid %d)\n", hipGetErrorString(e), grid_blocks);
}
```
